# Optimizing an MI355X kernel written in HIP

```python
import math
import jax, jax.numpy as jnp
from jax import lax
import numpy as np

D_MODEL = 1024
BATCH = 8
SEQ = 2048
DEPTH = 1
DEC_BATCH = 128
DEC_SEQ = 8
PAST_LEN = 16384
PAGE_SIZE = 128

MIX_WIDTH = D_MODEL
A_GROUPS = 4
A_WIDTH = MIX_WIDTH // 2
A_CH = A_WIDTH // A_GROUPS
CHUNK = 128
R_HEADS = 4
R_WIDTH = MIX_WIDTH - A_WIDTH
R_DK = R_WIDTH // R_HEADS
R_DV = R_WIDTH // R_HEADS
RET_CHUNK = 128
ROPE_BASE = 10000.0
IN_WIDTH = 2 * A_WIDTH + 4 * R_WIDTH
N_MEM = 256
CA_HEADS = 4
CA_DH = D_MODEL // CA_HEADS
PEER_HEADS = 8
PEER_KEYS = 128
PEER_EXPERTS = PEER_KEYS * PEER_KEYS
PEER_TOPK = 16
PEER_DKEY = 256
PEER_DHALF = PEER_DKEY // 2
PEER_BLOCK = 128
ALPHA = (2 * DEPTH) ** 0.25
BETA = (8 * DEPTH) ** -0.25
LN_EPS = 1e-5

kernel_name = 'hybrid_gmlp_retention_peer_step'


def layer_norm(x, g, b):
    xf = x.astype(jnp.float32)
    mu = xf.mean(-1, keepdims=True)
    var = jnp.square(xf - mu).mean(-1, keepdims=True)
    return ((xf - mu) * lax.rsqrt(var + LN_EPS)).astype(x.dtype) * g + b


def rotary(x, pos):
    half = x.shape[-1] // 2
    inv = 1.0 / (ROPE_BASE ** (jnp.arange(half, dtype=jnp.float32) / half))
    ang = pos.astype(jnp.float32)[:, None] * inv[None, :]
    cos = jnp.cos(ang)[None, :, None, :]
    sin = jnp.sin(ang)[None, :, None, :]
    x1, x2 = x[..., :half], x[..., half:]
    return jnp.concatenate([x1 * cos - x2 * sin, x1 * sin + x2 * cos], axis=-1)


def spatial_gate(u, v, w_s, b_s, g, b):
    B, L = v.shape[0], v.shape[1]
    v = layer_norm(v, g, b)
    Lp = -(-L // CHUNK) * CHUNK
    vp = jnp.pad(v, ((0, 0), (0, Lp - L), (0, 0), (0, 0))).reshape(B, Lp // CHUNK, CHUNK, A_GROUPS, A_CH)
    ws = w_s * jnp.tril(jnp.ones((CHUNK, CHUNK), w_s.dtype))
    mixed = jnp.einsum('gts,bnsgc->bntgc', ws, vp) + b_s.T[None, None, :, :, None]
    mixed = mixed.reshape(B, Lp, A_GROUPS, A_CH)[:, :L]
    return u * mixed, v


def retention(q, k, v, s0):
    B, L, H = q.shape[0], q.shape[1], q.shape[2]
    C = RET_CHUNK if L % RET_CHUNK == 0 else L
    n = L // C
    lg = jnp.log(1.0 - 2.0 ** (-5.0 - jnp.arange(H, dtype=jnp.float32)))
    i = jnp.arange(C, dtype=jnp.float32)
    diff = i[:, None] - i[None, :]
    dmask = jnp.where(diff[None] >= 0, jnp.exp(jnp.maximum(diff, 0.0)[None] * lg[:, None, None]), 0.0)
    q_dec = jnp.exp((i + 1.0)[:, None] * lg[None, :])
    k_dec = jnp.exp((C - 1.0 - i)[:, None] * lg[None, :])
    c_dec = jnp.exp(C * lg)

    def step(S, blk):
        qc, kc, vc = blk
        inner = jnp.einsum('bihd,bjhd->bhij', qc, kc) * dmask
        o = (jnp.einsum('bhij,bjhe->bihe', inner, vc)
             + jnp.einsum('bihd,bhde->bihe', qc, S) * q_dec[None, :, :, None])
        S = S * c_dec[None, :, None, None] + jnp.einsum('bjhd,bjhe->bhde', kc * k_dec[None, :, :, None], vc)
        return S, o

    def split(t):
        return t.reshape(B, n, C, H, t.shape[-1]).transpose(1, 0, 2, 3, 4)

    S, o = lax.scan(step, s0, (split(q), split(k), split(v)))
    o = o.transpose(1, 0, 2, 3, 4).reshape(B, L, H, v.shape[-1])
    return o, S


def peer(x, wq, subkeys, u_tab, v_tab):
    T, D = x.shape
    pad = (-T) % PEER_BLOCK
    xb = jnp.pad(x, ((0, pad), (0, 0))).reshape(-1, PEER_BLOCK, D)
    ncand = PEER_TOPK * PEER_TOPK

    def block(xt):
        q = (xt @ wq).reshape(PEER_BLOCK, PEER_HEADS, 2, PEER_DHALF)
        s = jnp.einsum('thcd,hckd->thck', q, subkeys).astype(jnp.float32)
        sv, si = lax.top_k(s, PEER_TOPK)
        cand = (sv[:, :, 0, :, None] + sv[:, :, 1, None, :]).reshape(PEER_BLOCK, PEER_HEADS, ncand)
        cidx = (si[:, :, 0, :, None] * PEER_KEYS + si[:, :, 1, None, :]).reshape(PEER_BLOCK, PEER_HEADS, ncand)
        fv, fi = lax.top_k(cand, PEER_TOPK)
        eidx = jnp.take_along_axis(cidx, fi, axis=-1)
        g = jax.nn.softmax(fv, axis=-1).astype(xt.dtype)
        act = jax.nn.gelu(jnp.einsum('thed,td->the', u_tab[eidx], xt))
        return jnp.einsum('the,thed->td', g * act, v_tab[eidx])

    return lax.map(block, xb).reshape(-1, D)[:T]


def layer(x, pos0, mem_k, mem_v, ret_s0, w_in, w_s, b_s, gate_ln_g, gate_ln_b, ret_gn_g, ret_gn_b,
          w_o, ln1_g, ln1_b, ca_wq, ca_wo, ln2_g, ln2_b, peer_wq, peer_subkeys, peer_u, peer_v,
          ln3_g, ln3_b):
    B, L, D = x.shape
    f32 = jnp.float32
    h = x @ w_in
    cuts = [A_WIDTH, 2 * A_WIDTH, 2 * A_WIDTH + R_WIDTH, 2 * A_WIDTH + 2 * R_WIDTH, 2 * A_WIDTH + 3 * R_WIDTH]
    ua, va, qr, kr, vr, gr = jnp.split(h, cuts, axis=-1)
    ua = jax.nn.gelu(ua).reshape(B, L, A_GROUPS, A_CH)
    va = jax.nn.gelu(va).reshape(B, L, A_GROUPS, A_CH)
    a_out, va_n = spatial_gate(ua, va, w_s, b_s, gate_ln_g, gate_ln_b)
    pos = pos0 + jnp.arange(L, dtype=jnp.int32)
    q = rotary(qr.reshape(B, L, R_HEADS, R_DK).astype(f32), pos)
    k = rotary(kr.reshape(B, L, R_HEADS, R_DK).astype(f32), pos) * (R_DK ** -0.5)
    v = vr.reshape(B, L, R_HEADS, R_DV).astype(f32)
    o, s_new = retention(q, k, v, ret_s0.astype(f32))
    o = layer_norm(o, ret_gn_g.astype(f32), ret_gn_b.astype(f32)).astype(x.dtype)
    r_out = jax.nn.silu(gr) * o.reshape(B, L, R_WIDTH)
    mix = jnp.concatenate([a_out.reshape(B, L, A_WIDTH), r_out], axis=-1) @ w_o
    x = layer_norm(ALPHA * x + mix, ln1_g, ln1_b)
    qc = (x @ ca_wq).reshape(B, L, CA_HEADS, CA_DH)
    sc = jnp.einsum('blhd,bmhd->bhlm', qc, mem_k).astype(f32) * (CA_DH ** -0.5)
    p = jax.nn.softmax(sc, axis=-1).astype(x.dtype)
    ca = jnp.einsum('bhlm,bmhd->blhd', p, mem_v).reshape(B, L, D) @ ca_wo
    x = layer_norm(ALPHA * x + ca, ln2_g, ln2_b)
    f = peer(x.reshape(B * L, D), peer_wq, peer_subkeys, peer_u, peer_v).reshape(B, L, D)
    x = layer_norm(ALPHA * x + f, ln3_g, ln3_b)
    return x, s_new.astype(ret_s0.dtype), va_n


def setup_inputs(seed: int = 0) -> dict:
    key = jax.random.key(seed)
    ks = jax.random.split(key, 32)
    f32 = jnp.float32

    def nrm(i, shape, scale):
        return jax.random.normal(ks[i], shape, f32) * scale

    def gain(i, shape):
        return 1.0 + nrm(i, shape, 0.02)

    D = D_MODEL
    return {
        'x_prompt': nrm(0, (BATCH, SEQ, D), 1.0),
        'x_sample': nrm(1, (DEC_BATCH, DEC_SEQ, D), 1.0),
        'mem_prompt': nrm(2, (BATCH, N_MEM, D), 1.0),
        'cache_mem_k': nrm(3, (DEPTH, DEC_BATCH, N_MEM, CA_HEADS, CA_DH), 1.0),
        'cache_mem_v': nrm(4, (DEPTH, DEC_BATCH, N_MEM, CA_HEADS, CA_DH), 1.0),
        'state_ret': nrm(5, (DEPTH, DEC_BATCH, R_HEADS, R_DK, R_DV), 0.1),
        'w_in': nrm(6, (DEPTH, D, IN_WIDTH), D ** -0.5),
        'w_s': nrm(7, (DEPTH, A_GROUPS, CHUNK, CHUNK), CHUNK ** -0.5),
        'b_s': gain(8, (DEPTH, A_GROUPS, CHUNK)),
        'gate_ln_g': gain(9, (DEPTH, A_GROUPS, A_CH)),
        'gate_ln_b': nrm(10, (DEPTH, A_GROUPS, A_CH), 0.02),
        'ret_gn_g': gain(11, (DEPTH, R_HEADS, R_DV)),
        'ret_gn_b': nrm(12, (DEPTH, R_HEADS, R_DV), 0.02),
        'w_o': nrm(13, (DEPTH, MIX_WIDTH, D), BETA * MIX_WIDTH ** -0.5),
        'ln1_g': gain(14, (DEPTH, D)),
        'ln1_b': nrm(15, (DEPTH, D), 0.02),
        'ca_wq': nrm(16, (DEPTH, D, D), D ** -0.5),
        'ca_wk': nrm(17, (DEPTH, D, D), D ** -0.5),
        'ca_wv': nrm(18, (DEPTH, D, D), D ** -0.5),
        'ca_wo': nrm(19, (DEPTH, D, D), BETA * D ** -0.5),
        'ln2_g': gain(20, (DEPTH, D)),
        'ln2_b': nrm(21, (DEPTH, D), 0.02),
        'peer_wq': nrm(22, (DEPTH, D, PEER_HEADS * PEER_DKEY), D ** -0.5),
        'peer_subkeys': nrm(23, (DEPTH, PEER_HEADS, 2, PEER_KEYS, PEER_DHALF), PEER_DHALF ** -0.5),
        'peer_u': nrm(24, (DEPTH, PEER_EXPERTS, D), D ** -0.5),
        'peer_v': nrm(25, (DEPTH, PEER_EXPERTS, D), BETA * PEER_HEADS ** -0.5),
        'ln3_g': gain(26, (DEPTH, D)),
        'ln3_b': nrm(27, (DEPTH, D), 0.02),
    }


def reference(x_prompt, x_sample, mem_prompt, cache_mem_k, cache_mem_v, state_ret, w_in, w_s, b_s,
              gate_ln_g, gate_ln_b, ret_gn_g, ret_gn_b, w_o, ln1_g, ln1_b, ca_wq, ca_wk, ca_wv, ca_wo,
              ln2_g, ln2_b, peer_wq, peer_subkeys, peer_u, peer_v, ln3_g, ln3_b):
    yp, ys = x_prompt, x_sample
    bp = x_prompt.shape[0]
    mk_l, mv_l, sp_l, ss_l, gv_l = [], [], [], [], []
    for l in range(DEPTH):
        lw = (w_in[l], w_s[l], b_s[l], gate_ln_g[l], gate_ln_b[l], ret_gn_g[l], ret_gn_b[l], w_o[l],
              ln1_g[l], ln1_b[l], ca_wq[l], ca_wo[l], ln2_g[l], ln2_b[l], peer_wq[l], peer_subkeys[l],
              peer_u[l], peer_v[l], ln3_g[l], ln3_b[l])
        mem_k = (mem_prompt @ ca_wk[l]).reshape(bp, N_MEM, CA_HEADS, CA_DH)
        mem_v = (mem_prompt @ ca_wv[l]).reshape(bp, N_MEM, CA_HEADS, CA_DH)
        s0 = jnp.zeros((bp, R_HEADS, R_DK, R_DV), x_prompt.dtype)
        yp, sp, _ = layer(yp, 0, mem_k, mem_v, s0, *lw)
        ys, ss, gv = layer(ys, PAST_LEN, cache_mem_k[l], cache_mem_v[l], state_ret[l], *lw)
        mk_l.append(mem_k)
        mv_l.append(mem_v)
        sp_l.append(sp)
        ss_l.append(ss)
        gv_l.append(gv)
    new_mem_k = jnp.stack(mk_l)
    new_mem_v = jnp.stack(mv_l)
    new_ret_prompt = jnp.stack(sp_l)
    new_ret_sample = jnp.stack(ss_l)
    new_gate_v_sample = jnp.stack(gv_l)
    return (yp, ys, new_mem_k, new_mem_v, new_ret_prompt, new_ret_sample, new_gate_v_sample)
```

```cpp
#include <hip/hip_runtime.h>
#include <hip/hip_cooperative_groups.h>
#include <cstdio>
#include <cstdint>
#include <cstring>
namespace cg = cooperative_groups;

#define NT 512
#define DEVINL __device__ __forceinline__
#ifndef PHASES
#define PHASES 0xFFFF
#endif
#define PH(k) ((PHASES >> (k)) & 1)
#ifndef RPT_MASK
#define RPT_MASK 0x0
#endif
#define RPT(k) for (int rep_ = 0; rep_ < 1 + ((RPT_MASK >> (k)) & 1); rep_++)
#ifndef USE_CG_SYNC
#define USE_CG_SYNC 0
#endif

typedef unsigned short u16;
typedef short bf16x8 __attribute__((ext_vector_type(8)));
typedef short s4v __attribute__((ext_vector_type(4)));
typedef float f32x4 __attribute__((ext_vector_type(4)));

constexpr int T_ALL = 17408;
constexpr int T_P = 16384;
constexpr float ALPHA_F = 1.189207115002721f;
constexpr float LN_EPS_F = 1e-5f;
constexpr int SMEM_BYTES = 139264;

struct Params {
  const float *x_prompt, *x_sample, *mem_prompt, *cache_k, *cache_v, *state_ret, *w_in, *w_s, *b_s,
      *gate_ln_g, *gate_ln_b, *ret_gn_g, *ret_gn_b, *w_o, *ln1_g, *ln1_b, *ca_wq, *ca_wk, *ca_wv, *ca_wo,
      *ln2_g, *ln2_b, *peer_wq, *peer_subkeys, *peer_u, *peer_v, *ln3_g, *ln3_b;
  float *Y, *new_mem_k, *new_mem_v, *new_ret_prompt, *new_ret_sample, *new_gate_v;
  unsigned char *Ub8, *Vb8, *Ub4, *Vb4;
  float* Vsc4;
  float *Usc, *Vsc;
  u16 *QKR, *WinT, *WoT, *WqT, *WkvT, *WcoT, *PwqT, *SubK, *Ub, *Vb, *Xb, *Memb, *Hb, *MemKVb, *MIXIN, *QC, *CA, *PQ;
  float *rope_cos, *rope_sin, *U, *SELG;
  u16* PREb;
  u16* SP;
  int* SELI;
  unsigned* bar;
};

typedef __bf16 bf16v2 __attribute__((ext_vector_type(2)));
typedef float f32v2 __attribute__((ext_vector_type(2)));
DEVINL unsigned pk2(float a, float b) {
  f32v2 v = {a, b};
  union { bf16v2 h; unsigned u; } c;
  c.h = __builtin_convertvector(v, bf16v2);
  return c.u;
}
DEVINL u16 f2bf(float f) { return (u16)(pk2(f, 0.f) & 0xffffu); }
DEVINL float bflo(unsigned u) { return __uint_as_float(u << 16); }
DEVINL float bfhi(unsigned u) { return __uint_as_float(u & 0xffff0000u); }
DEVINL float bf1(u16 h) { return __uint_as_float(((unsigned)h) << 16); }
DEVINL void unpack8(const uint4& r, float* x) {
  x[0] = bflo(r.x); x[1] = bfhi(r.x); x[2] = bflo(r.y); x[3] = bfhi(r.y);
  x[4] = bflo(r.z); x[5] = bfhi(r.z); x[6] = bflo(r.w); x[7] = bfhi(r.w);
}
DEVINL uint4 pack8(const float* x) {
  uint4 o; o.x = pk2(x[0], x[1]); o.y = pk2(x[2], x[3]); o.z = pk2(x[4], x[5]); o.w = pk2(x[6], x[7]);
  return o;
}
DEVINL bf16x8 as_frag(const uint4& r) {
  union { uint4 u; bf16x8 f; } c; c.u = r; return c.f;
}
DEVINL f32x4 mfma16(bf16x8 a, bf16x8 b, f32x4 c) { return __builtin_amdgcn_mfma_f32_16x16x32_bf16(a, b, c, 0, 0, 0); }
DEVINL float gelu_tanh(float x) {
  float u = 0.7978845608028654f * (x + 0.044715f * x * x * x);
  float e = __expf(2.0f * u);
  float t = 1.0f - 2.0f * __builtin_amdgcn_rcpf(e + 1.0f);
  return 0.5f * x * (1.0f + t);
}
DEVINL float silu_f(float x) { return x * __builtin_amdgcn_rcpf(1.0f + __expf(-x)); }
DEVINL int sw128(int r, int c) { return r * 128 + ((c ^ (r & 7)) << 4); }
DEVINL int sw256(int r, int c) { return r * 256 + ((c ^ (r & 15)) << 4); }
DEVINL int sw512(int r, int c) { return r * 512 + ((c ^ (r & 15)) << 4); }
DEVINL bf16x8 lds_frag(const char* p) { return *(const bf16x8*)p; }
DEVINL s4v tr_read(const char* p) {
  return __builtin_amdgcn_ds_read_tr16_b64_v4i16((__attribute__((address_space(3))) s4v*)p);
}
DEVINL bf16x8 tr_frag(const char* base, int stride, int k0, int c0, int lane) {
  int grp = lane >> 4, q = (lane >> 2) & 3, pp = lane & 3;
  const char* a0 = base + (k0 + 8 * grp + q) * stride + (c0 + 4 * pp) * 2;
  s4v lo = tr_read(a0), hi = tr_read(a0 + 4 * stride);
  bf16x8 r; r[0] = lo[0]; r[1] = lo[1]; r[2] = lo[2]; r[3] = lo[3]; r[4] = hi[0]; r[5] = hi[1]; r[6] = hi[2]; r[7] = hi[3];
  return r;
}
DEVINL bf16x8 tr_frag_perm(const char* base, int stride, int k0, int c0, int lane) {
  int grp = lane >> 4, q = (lane >> 2) & 3, pp = lane & 3;
  const char* a0 = base + (k0 + 4 * grp + q) * stride + (c0 + 4 * pp) * 2;
  s4v lo = tr_read(a0), hi = tr_read(a0 + 16 * stride);
  bf16x8 r; r[0] = lo[0]; r[1] = lo[1]; r[2] = lo[2]; r[3] = lo[3]; r[4] = hi[0]; r[5] = hi[1]; r[6] = hi[2]; r[7] = hi[3];
  return r;
}
DEVINL bf16x8 pack_frag(const f32x4& a, const f32x4& b) {
  uint4 o; o.x = pk2(a[0], a[1]); o.y = pk2(a[2], a[3]); o.z = pk2(b[0], b[1]); o.w = pk2(b[2], b[3]);
  return as_frag(o);
}
DEVINL float wave_sum(float v) {
#pragma unroll
  for (int o = 32; o >= 1; o >>= 1) v += __shfl_xor(v, o);
  return v;
}
DEVINL const float* xin_row(const Params& p, int m) {
  return (m < T_P) ? (p.x_prompt + (size_t)m * 1024) : (p.x_sample + (size_t)(m - T_P) * 1024);
}

DEVINL int get_tid() { int t = threadIdx.x; asm volatile("" : "+v"(t)); return t; }

#define XB_TMO      128
#define XB_XCNT(j)  (256  + 64 * (j))
#define XB_XSUB(j)  (1280 + 64 * (j))
#define XB_XGEN(j)  (2304 + 64 * (j))
#define XB_TOP      3328
#define XB_TOPGEN   3392
#define XCD_BAR_WORDS 3456
#define XB_SPIN_CAP (1u << 22)
#define LAS __attribute__((address_space(3)))
DEVINL unsigned xb_ld(unsigned* p) { return __hip_atomic_load(p, __ATOMIC_RELAXED, __HIP_MEMORY_SCOPE_AGENT); }
DEVINL unsigned xb_add(unsigned* p, unsigned v) { return __hip_atomic_fetch_add(p, v, __ATOMIC_RELAXED, __HIP_MEMORY_SCOPE_AGENT); }
DEVINL unsigned xb_xcc_id() { return (unsigned)__builtin_amdgcn_s_getreg((3 << 11) | 20) & 0xFu; }
#define XB_SPIN(cond, bar) do { unsigned _sp = 0; while (cond) { __builtin_amdgcn_s_sleep(1); \
    if ((++_sp & 255u) == 0u) { if (xb_ld(&(bar)[XB_TMO])) break; if (_sp > XB_SPIN_CAP) { atomicAdd(&(bar)[XB_TMO], 1u); break; } } } } while (0)
struct XcdBarrier { unsigned* bar; unsigned x; volatile LAS unsigned* st; };
DEVINL XcdBarrier xcd_barrier_post(unsigned* bar, volatile LAS unsigned* st) {
  XcdBarrier b; b.bar = bar; b.x = xb_xcc_id(); b.st = st;
  if (threadIdx.x == 0) (void)xb_add(&bar[XB_XCNT(b.x)], 1u);
  return b;
}
DEVINL void xcd_barrier_complete(unsigned* bar, unsigned x, unsigned& nloc, unsigned& nx) {
  const unsigned G = gridDim.x * gridDim.y * gridDim.z;
  unsigned sum, cnt, mine, sp = 0u;
  for (;;) {
    sum = 0u; cnt = 0u; mine = 0u;
#pragma unroll
    for (unsigned j = 0; j < 16; ++j) { const unsigned c = xb_ld(&bar[XB_XCNT(j)]); sum += c; cnt += (c > 0u) ? 1u : 0u; mine = (j == x) ? c : mine; }
    if (sum == G) break;
    __builtin_amdgcn_s_sleep(1);
    if ((++sp & 255u) == 0u) { if (xb_ld(&bar[XB_TMO])) break; if (sp > XB_SPIN_CAP) { atomicAdd(&bar[XB_TMO], 1u); break; } }
  }
  nloc = mine > 0u ? mine : 1u; nx = cnt > 0u ? cnt : 1u;
}
DEVINL void xcd_barrier(const XcdBarrier& b) {
  asm volatile("s_waitcnt vmcnt(0)" ::: "memory");
  __syncthreads();
  if (threadIdx.x == 0) {
    unsigned* bar = b.bar;
    __builtin_amdgcn_s_waitcnt(0);
    unsigned nloc = b.st[0], nx = b.st[1];
    if (nloc == 0u) { xcd_barrier_complete(bar, b.x, nloc, nx); b.st[0] = nloc; b.st[1] = nx; }
    const unsigned old = xb_add(&bar[XB_XSUB(b.x)], 1u);
    const unsigned gen = old / nloc;
    if (old + 1u == (gen + 1u) * nloc) {
      __builtin_amdgcn_fence(__ATOMIC_RELEASE, "agent");
      asm volatile("s_waitcnt vmcnt(0)" ::: "memory");
      const unsigned og = xb_add(&bar[XB_TOP], 1u);
      const unsigned tg = og / nx;
      if (og + 1u == (tg + 1u) * nx) xb_add(&bar[XB_TOPGEN], 1u);
      else XB_SPIN(xb_ld(&bar[XB_TOPGEN]) == tg, bar);
      __builtin_amdgcn_fence(__ATOMIC_ACQUIRE, "agent");
      xb_add(&bar[XB_XGEN(b.x)], 1u);
      asm volatile("s_waitcnt vmcnt(0)" ::: "memory");
    } else {
      XB_SPIN(xb_ld(&bar[XB_XGEN(b.x)]) == gen, bar);
      __builtin_amdgcn_fence(__ATOMIC_ACQUIRE, "agent");
      asm volatile("s_waitcnt vmcnt(0)" ::: "memory");
    }
  }
  __syncthreads();
}
#define grid_barrier(p, epoch) xcd_barrier(xb)

DEVINL void cvt_range(const float* __restrict__ src, u16* __restrict__ dst, size_t n8) {
  size_t stride = (size_t)gridDim.x * NT;
  const int tid_ = get_tid();
  for (size_t i = (size_t)blockIdx.x * NT + tid_; i < n8; i += stride) {
    float4 a = ((const float4*)src)[2 * i], b = ((const float4*)src)[2 * i + 1];
    uint4 o; o.x = pk2(a.x, a.y); o.y = pk2(a.z, a.w); o.z = pk2(b.x, b.y); o.w = pk2(b.z, b.w);
    ((uint4*)dst)[i] = o;
  }
}
DEVINL void transpose_tile(const float* __restrict__ W, int N, u16* __restrict__ WT, int tile, float* tl) {
  const int tid = get_tid();
  int ntn = N >> 6;
  int kt = tile / ntn, nt = tile - kt * ntn;
  int k0 = kt * 64, n0 = nt * 64;
#pragma unroll
  for (int i = 0; i < 2; i++) {
    int r = (tid >> 4) + 32 * i, c4 = (tid & 15) * 4;
    float4 v = *(const float4*)(W + (size_t)(k0 + r) * N + n0 + c4);
    tl[(c4 + 0) * 65 + r] = v.x; tl[(c4 + 1) * 65 + r] = v.y; tl[(c4 + 2) * 65 + r] = v.z; tl[(c4 + 3) * 65 + r] = v.w;
  }
  __syncthreads();
  {
    int n = tid >> 3, k8 = (tid & 7) * 8;
    float x[8];
#pragma unroll
    for (int j = 0; j < 8; j++) x[j] = tl[n * 65 + k8 + j];
    *(uint4*)(WT + (size_t)(n0 + n) * 1024 + k0 + k8) = pack8(x);
  }
  __syncthreads();
}
DEVINL void quant_rows(const Params& p, int r0, int r1, int hb, int nh) {
  const int tid_ = get_tid(); const int lane = tid_ & 63, wid = __builtin_amdgcn_readfirstlane(tid_ >> 6);
  for (int rr = r0 + hb * 8 + wid; rr < r1; rr += nh * 8) {
    const bool isv = rr >= 16384;
    const int row = isv ? rr - 16384 : rr;
    const float* src = isv ? p.peer_v : p.peer_u;
    unsigned char* dst = isv ? p.Vb8 : p.Ub8;
    float* inv_scale = isv ? p.Vsc : p.Usc;
    const float* rp = src + (size_t)row * 1024 + lane * 16;
    float4 a = *(const float4*)rp, b = *(const float4*)(rp + 4), c = *(const float4*)(rp + 8), d = *(const float4*)(rp + 12);
    float m = fmaxf(fmaxf(fmaxf(fabsf(a.x), fabsf(a.y)), fmaxf(fabsf(a.z), fabsf(a.w))), fmaxf(fmaxf(fabsf(b.x), fabsf(b.y)), fmaxf(fabsf(b.z), fabsf(b.w))));
    m = fmaxf(m, fmaxf(fmaxf(fmaxf(fabsf(c.x), fabsf(c.y)), fmaxf(fabsf(c.z), fabsf(c.w))), fmaxf(fmaxf(fabsf(d.x), fabsf(d.y)), fmaxf(fabsf(d.z), fabsf(d.w)))));
#pragma unroll
    for (int o = 32; o >= 1; o >>= 1) m = fmaxf(m, __shfl_xor(m, o));
    if (isv) {
      const float sc = m > 0.f ? 224.0f / m : 1.0f;
      uint4 q;
      int w0 = 0, w1 = 0, w2 = 0, w3 = 0;
      w0 = __builtin_amdgcn_cvt_pk_fp8_f32(a.x * sc, a.y * sc, w0, false); w0 = __builtin_amdgcn_cvt_pk_fp8_f32(a.z * sc, a.w * sc, w0, true);
      w1 = __builtin_amdgcn_cvt_pk_fp8_f32(b.x * sc, b.y * sc, w1, false); w1 = __builtin_amdgcn_cvt_pk_fp8_f32(b.z * sc, b.w * sc, w1, true);
      w2 = __builtin_amdgcn_cvt_pk_fp8_f32(c.x * sc, c.y * sc, w2, false); w2 = __builtin_amdgcn_cvt_pk_fp8_f32(c.z * sc, c.w * sc, w2, true);
      w3 = __builtin_amdgcn_cvt_pk_fp8_f32(d.x * sc, d.y * sc, w3, false); w3 = __builtin_amdgcn_cvt_pk_fp8_f32(d.z * sc, d.w * sc, w3, true);
      q.x = (unsigned)w0; q.y = (unsigned)w1; q.z = (unsigned)w2; q.w = (unsigned)w3;
      *(uint4*)(dst + (size_t)row * 1024 + lane * 16) = q;
      if (lane == 0) inv_scale[row] = m > 0.f ? m / 224.0f : 1.0f;
    }
    {
      const float xv[16] = {a.x, a.y, a.z, a.w, b.x, b.y, b.z, b.w, c.x, c.y, c.z, c.w, d.x, d.y, d.z, d.w};
      float ss = 0.f;
#pragma unroll
      for (int i = 0; i < 16; i++) ss += xv[i] * xv[i];
      ss = wave_sum(ss);
      float clipv = 2.6f * sqrtf(ss * (1.0f / 1024.0f));
      clipv = fminf(clipv, m);
      const float sc = clipv > 0.f ? 7.0f / clipv : 1.0f;
      unsigned w0 = 0u, w1 = 0u;
#pragma unroll
      for (int i = 0; i < 8; i++) {
        int q0 = (int)rintf(xv[i] * sc), q1 = (int)rintf(xv[i + 8] * sc);
        q0 = q0 < -7 ? -7 : (q0 > 7 ? 7 : q0); q1 = q1 < -7 ? -7 : (q1 > 7 ? 7 : q1);
        w0 |= (isv ? (unsigned)(q0 + 8) : ((unsigned)q0 & 15u)) << (4 * i);
        w1 |= (isv ? (unsigned)(q1 + 8) : ((unsigned)q1 & 15u)) << (4 * i);
      }
      *(uint2*)((isv ? p.Vb4 : p.Ub4) + (size_t)row * 512 + lane * 8) = make_uint2(w0, w1);
      if (lane == 0) (isv ? p.Vsc4 : p.Usc)[row] = clipv > 0.f ? clipv / 7.0f : 1.0f;
    }
  }
}
DEVINL void prep_phase(const Params& p, char* smem) {
  float* tl = (float*)smem;
  for (int t = blockIdx.x; t < 2560; t += gridDim.x) {
    if (t < 768) transpose_tile(p.w_in, 3072, p.WinT, t, tl);
    else if (t < 1024) transpose_tile(p.w_o, 1024, p.WoT, t - 768, tl);
    else if (t < 1280) transpose_tile(p.ca_wq, 1024, p.WqT, t - 1024, tl);
    else if (t < 1536) transpose_tile(p.ca_wk, 1024, p.WkvT, t - 1280, tl);
    else if (t < 1792) transpose_tile(p.ca_wv, 1024, p.WkvT + (size_t)1024 * 1024, t - 1536, tl);
    else if (t < 2048) transpose_tile(p.ca_wo, 1024, p.WcoT, t - 1792, tl);
    else transpose_tile(p.peer_wq, 2048, p.PwqT, t - 2048, tl);
  }
  cvt_range(p.x_prompt, p.Xb, (size_t)T_P * 1024 / 8);
  cvt_range(p.x_sample, p.Xb + (size_t)T_P * 1024, (size_t)1024 * 1024 / 8);
  cvt_range(p.mem_prompt, p.Memb, (size_t)2048 * 1024 / 8);
  cvt_range(p.peer_subkeys, p.SubK, (size_t)262144 / 8);
  for (int i = blockIdx.x * NT + get_tid(); i < 2056 * 64; i += gridDim.x * NT) {
    int pr = i >> 6, j = i & 63;
    int pos = pr < 2048 ? pr : 16384 + (pr - 2048);
    float inv = (float)exp(-((double)j / 64.0) * 9.210340371976184);
    float ang = (float)pos * inv;
    double a = (double)ang;
    double k = rint(a * 0.15915494309189535);
    double r = fma(-k, 6.283185307179586, a);
    r = fma(-k, 2.4492935982947064e-16, r);
    float rf = (float)r;
    float s, c;
    sincosf(rf, &s, &c);
    p.rope_cos[i] = c;
    p.rope_sin[i] = s;
  }
}

typedef unsigned int u32x4 __attribute__((ext_vector_type(4)));
struct Stg { u32x4 a0, a1, b0, b1, b2, b3; };
template <int BCH>
DEVINL void g_load(Stg& s, const u16* Ap, const u16* Bp, int kt) {
  s.a0 = *(const u32x4*)(Ap + kt * 64);
  s.a1 = *(const u32x4*)(Ap + (size_t)64 * 1024 + kt * 64);
  s.b0 = *(const u32x4*)(Bp + kt * 64);
  s.b1 = *(const u32x4*)(Bp + (size_t)64 * 1024 + kt * 64);
  if (BCH == 4) {
    s.b2 = *(const u32x4*)(Bp + (size_t)128 * 1024 + kt * 64);
    s.b3 = *(const u32x4*)(Bp + (size_t)192 * 1024 + kt * 64);
  }
}
template <int BCH>
DEVINL void s_store(const Stg& s, char* da, int lr, int lc) {
  *(u32x4*)(da + sw128(lr, lc)) = s.a0;
  *(u32x4*)(da + sw128(lr + 64, lc)) = s.a1;
  char* db = da + 128 * 128;
  *(u32x4*)(db + sw128(lr, lc)) = s.b0;
  *(u32x4*)(db + sw128(lr + 64, lc)) = s.b1;
  if (BCH == 4) {
    *(u32x4*)(db + sw128(lr + 128, lc)) = s.b2;
    *(u32x4*)(db + sw128(lr + 192, lc)) = s.b3;
  }
}
template <int BN, int NTW>
DEVINL void g_compute(f32x4 (&acc)[4][NTW], const char* sa, int wm, int wn, int l15, int g4) {
  const char* sb = sa + 128 * 128;
#pragma unroll
  for (int ks = 0; ks < 2; ks++) {
    bf16x8 af[4], bfr[NTW];
    const int c = ks * 4 + g4;
#pragma unroll
    for (int mi = 0; mi < 4; mi++) af[mi] = lds_frag(sa + sw128(wm * 64 + mi * 16 + l15, c));
#pragma unroll
    for (int ni = 0; ni < NTW; ni++) bfr[ni] = lds_frag(sb + sw128(wn * (BN / 4) + ni * 16 + l15, c));
#pragma unroll
    for (int mi = 0; mi < 4; mi++)
#pragma unroll
      for (int ni = 0; ni < NTW; ni++) acc[mi][ni] = mfma16(bfr[ni], af[mi], acc[mi][ni]);
  }
}
template <int BN, class Epi>
DEVINL void gemm_tile(const u16* __restrict__ A, const u16* __restrict__ Bt, int m0, int n0, char* smem, Epi epi) {
  constexpr int K = 1024, NKT = 16;
  constexpr int NTW = BN / 64;
  constexpr int STAGE = 128 * 128 + BN * 128;
  constexpr int BCH = BN * 8 / NT;
  const int tid = get_tid(), lane = tid & 63, wid = tid >> 6, wm = wid >> 2, wn = wid & 3;
  const int l15 = lane & 15, g4 = lane >> 4;
  f32x4 acc[4][NTW];
#pragma unroll
  for (int i = 0; i < 4; i++)
#pragma unroll
    for (int j = 0; j < NTW; j++) acc[i][j] = (f32x4){0.f, 0.f, 0.f, 0.f};
  Stg s0, s1;
  const int lr = tid >> 3, lc = tid & 7;
  const u16* Ap = A + (size_t)(m0 + lr) * K + lc * 8;
  const u16* Bp = Bt + (size_t)(n0 + lr) * K + lc * 8;
  g_load<BCH>(s0, Ap, Bp, 0);
  s_store<BCH>(s0, smem, lr, lc);
  g_load<BCH>(s1, Ap, Bp, 1);
  g_load<BCH>(s0, Ap, Bp, 2);
  __syncthreads();
#pragma unroll 4
  for (int kt = 0; kt < NKT; kt += 2) {
    s_store<BCH>(s1, smem + STAGE, lr, lc);
    if (kt + 3 < NKT) g_load<BCH>(s1, Ap, Bp, kt + 3);
    g_compute<BN, NTW>(acc, smem, wm, wn, l15, g4);
    __syncthreads();
    if (kt + 2 < NKT) s_store<BCH>(s0, smem, lr, lc);
    if (kt + 4 < NKT) g_load<BCH>(s0, Ap, Bp, kt + 4);
    g_compute<BN, NTW>(acc, smem + STAGE, wm, wn, l15, g4);
    __syncthreads();
  }
#pragma unroll
  for (int mi = 0; mi < 4; mi++)
#pragma unroll
    for (int ni = 0; ni < NTW; ni++) {
      int m = m0 + wm * 64 + mi * 16 + l15;
      int n = n0 + wn * (BN / 4) + ni * 16 + g4 * 4;
      epi(m, n, acc[mi][ni]);
    }
}

template <int BN, class Coord, class Epi>
DEVINL void gemm_run(const u16* __restrict__ A, const u16* __restrict__ Bt, int t0, int t1, int tstep, Coord coord, char* smem, Epi epi) {
  if (t0 >= t1) return;
  constexpr int K = 1024, NKT = 16;
  constexpr int NTW = BN / 64;
  constexpr int STAGE = 128 * 128 + BN * 128;
  constexpr int BCH = BN * 8 / NT;
  const int tid = get_tid(), lane = tid & 63, wid = tid >> 6, wm = wid >> 2, wn = wid & 3;
  const int l15 = lane & 15, g4 = lane >> 4;
  const int lr = tid >> 3, lc = tid & 7;
  int m0, n0;
  coord(t0, m0, n0);
  const u16* Ap = A + (size_t)(m0 + lr) * K + lc * 8;
  const u16* Bp = Bt + (size_t)(n0 + lr) * K + lc * 8;
  Stg s0, s1;
  g_load<BCH>(s0, Ap, Bp, 0);
  g_load<BCH>(s1, Ap, Bp, 1);
  for (int t = t0; t < t1; t += tstep) {
    f32x4 acc[4][NTW];
#pragma unroll
    for (int i = 0; i < 4; i++)
#pragma unroll
      for (int j = 0; j < NTW; j++) acc[i][j] = (f32x4){0.f, 0.f, 0.f, 0.f};
    s_store<BCH>(s0, smem, lr, lc);
    g_load<BCH>(s0, Ap, Bp, 2);
    __syncthreads();
#pragma unroll 4
    for (int kt = 0; kt < NKT; kt += 2) {
      s_store<BCH>(s1, smem + STAGE, lr, lc);
      if (kt + 3 < NKT) g_load<BCH>(s1, Ap, Bp, kt + 3);
      g_compute<BN, NTW>(acc, smem, wm, wn, l15, g4);
      __syncthreads();
      if (kt + 2 < NKT) s_store<BCH>(s0, smem, lr, lc);
      if (kt + 4 < NKT) g_load<BCH>(s0, Ap, Bp, kt + 4);
      g_compute<BN, NTW>(acc, smem + STAGE, wm, wn, l15, g4);
      __syncthreads();
    }
    const int tn = t + tstep;
    int m0n = m0, n0n = n0;
    if (tn < t1) {
      coord(tn, m0n, n0n);
      Ap = A + (size_t)(m0n + lr) * K + lc * 8;
      Bp = Bt + (size_t)(n0n + lr) * K + lc * 8;
      g_load<BCH>(s0, Ap, Bp, 0);
      g_load<BCH>(s1, Ap, Bp, 1);
    }
#pragma unroll
    for (int mi = 0; mi < 4; mi++)
#pragma unroll
      for (int ni = 0; ni < NTW; ni++) {
        int m = m0 + wm * 64 + mi * 16 + l15;
        int n = n0 + wn * (BN / 4) + ni * 16 + g4 * 4;
        epi(m, n, acc[mi][ni]);
      }
    m0 = m0n; n0 = n0n;
  }
}
DEVINL int first_ge(int bid, int nb, int lo) { return bid >= lo ? bid : bid + ((lo - bid + nb - 1) / nb) * nb; }

DEVINL void ln_phase(const u16* __restrict__ pre, const float* __restrict__ gam, const float* __restrict__ bet,
                     u16* __restrict__ outb) {
  const int tid_ = get_tid(); const int lane = tid_ & 63, wid = __builtin_amdgcn_readfirstlane(tid_ >> 6);
  for (int row = blockIdx.x * 8 + wid; row < T_ALL; row += gridDim.x * 8) {
    float v[16];
    {
      uint4 a = *(const uint4*)(pre + (size_t)row * 1024 + lane * 8);
      uint4 b = *(const uint4*)(pre + (size_t)row * 1024 + 512 + lane * 8);
      unpack8(a, v); unpack8(b, v + 8);
    }
    float s = 0.f;
#pragma unroll
    for (int i = 0; i < 16; i++) s += v[i];
    float mean = wave_sum(s) * (1.0f / 1024.0f);
    float q = 0.f;
#pragma unroll
    for (int i = 0; i < 16; i++) { float d = v[i] - mean; q += d * d; }
    float rstd = rsqrtf(wave_sum(q) * (1.0f / 1024.0f) + LN_EPS_F);
#pragma unroll
    for (int hf = 0; hf < 2; hf++) {
      int col = hf * 512 + lane * 8;
      float4 g0 = *(const float4*)(gam + col), g1 = *(const float4*)(gam + col + 4);
      float4 b0 = *(const float4*)(bet + col), b1 = *(const float4*)(bet + col + 4);
      float y[8];
      const float* o = v + hf * 8;
      y[0] = (o[0] - mean) * rstd * g0.x + b0.x; y[1] = (o[1] - mean) * rstd * g0.y + b0.y;
      y[2] = (o[2] - mean) * rstd * g0.z + b0.z; y[3] = (o[3] - mean) * rstd * g0.w + b0.w;
      y[4] = (o[4] - mean) * rstd * g1.x + b1.x; y[5] = (o[5] - mean) * rstd * g1.y + b1.y;
      y[6] = (o[6] - mean) * rstd * g1.z + b1.z; y[7] = (o[7] - mean) * rstd * g1.w + b1.w;
      *(uint4*)(outb + (size_t)row * 1024 + col) = pack8(y);
    }
  }
}

DEVINL void gate_prompt_item(const Params& p, int id, char* smem) {
  const int tid = get_tid(), lane = tid & 63, wid = tid >> 6, l15 = lane & 15, g4 = lane >> 4;
  const int b = id >> 6, n = (id >> 2) & 15, g = id & 3;
  const int tok0 = b * 2048 + n * 128;
  char* WsL = smem;
  char* VnL = smem + 32768;
  const float* ws = p.w_s + g * 16384;
#pragma unroll
  for (int i = 0; i < 4; i++) {
    int q = tid + i * 512, t = q >> 4, c = q & 15, s0 = c * 8;
    float4 a = *(const float4*)(ws + t * 128 + s0), bb = *(const float4*)(ws + t * 128 + s0 + 4);
    float x[8] = {a.x, a.y, a.z, a.w, bb.x, bb.y, bb.z, bb.w};
#pragma unroll
    for (int j = 0; j < 8; j++) x[j] = (s0 + j <= t) ? x[j] : 0.f;
    *(uint4*)(WsL + sw256(t, c)) = pack8(x);
  }
#pragma unroll
  for (int i = 0; i < 4; i++) {
    int q = tid + i * 512, s = q >> 4, c = q & 15;
    uint4 raw = *(const uint4*)(p.Hb + (size_t)(tok0 + s) * 3072 + 512 + g * 128 + c * 8);
    float x[8]; unpack8(raw, x);
    float sum = 0.f;
#pragma unroll
    for (int j = 0; j < 8; j++) sum += x[j];
    sum += __shfl_xor(sum, 1); sum += __shfl_xor(sum, 2); sum += __shfl_xor(sum, 4); sum += __shfl_xor(sum, 8);
    float mean = sum * (1.0f / 128.0f);
    float var = 0.f;
#pragma unroll
    for (int j = 0; j < 8; j++) { float d = x[j] - mean; var += d * d; }
    var += __shfl_xor(var, 1); var += __shfl_xor(var, 2); var += __shfl_xor(var, 4); var += __shfl_xor(var, 8);
    float rstd = rsqrtf(var * (1.0f / 128.0f) + LN_EPS_F);
    const float* gp = p.gate_ln_g + g * 128 + c * 8;
    const float* bp = p.gate_ln_b + g * 128 + c * 8;
#pragma unroll
    for (int j = 0; j < 8; j++) x[j] = (x[j] - mean) * rstd * gp[j] + bp[j];
    *(uint4*)(VnL + s * 272 + c * 16) = pack8(x);
  }
  __syncthreads();
  f32x4 acc[8];
#pragma unroll
  for (int i = 0; i < 8; i++) acc[i] = (f32x4){0.f, 0.f, 0.f, 0.f};
#pragma unroll
  for (int ks = 0; ks < 4; ks++) {
    bf16x8 af = tr_frag(VnL, 272, 32 * ks, 16 * wid, lane);
#pragma unroll
    for (int ti = 0; ti < 8; ti++) {
      if (32 * ks <= 16 * ti + 15) {
        bf16x8 bw = lds_frag(WsL + sw256(16 * ti + l15, ks * 4 + g4));
        acc[ti] = mfma16(af, bw, acc[ti]);
      }
    }
  }
#pragma unroll
  for (int ti = 0; ti < 8; ti++) {
    int t = 16 * ti + l15, c = 16 * wid + 4 * g4, tok = tok0 + t;
    float bs = p.b_s[g * 128 + t];
    uint2 ua = *(const uint2*)(p.Hb + (size_t)tok * 3072 + g * 128 + c);
    float o0 = bflo(ua.x) * (acc[ti][0] + bs), o1 = bfhi(ua.x) * (acc[ti][1] + bs);
    float o2 = bflo(ua.y) * (acc[ti][2] + bs), o3 = bfhi(ua.y) * (acc[ti][3] + bs);
    uint2 o; o.x = pk2(o0, o1); o.y = pk2(o2, o3);
    *(uint2*)(p.MIXIN + (size_t)tok * 1024 + g * 128 + c) = o;
  }
  __syncthreads();
}

DEVINL void r1_item(const Params& p, int id, char* smem) {
  const int tid = get_tid(), lane = tid & 63, wid = tid >> 6, l15 = lane & 15, g4 = lane >> 4;
  const int b = id >> 6, h = (id >> 4) & 3, n = id & 15;
  const int tok0 = b * 2048 + n * 128;
  char* KL = smem;
  char* VL = smem + 34816;
  const float lg = logf(1.0f - exp2f(-5.0f - (float)h));
#pragma unroll
  for (int i = 0; i < 2; i++) {
    int q = tid + i * 512, j = q >> 3, ch = q & 7;
    int pr = n * 128 + j;
    float cs[8], sn[8];
    {
      float4 c0 = *(const float4*)(p.rope_cos + pr * 64 + ch * 8), c1 = *(const float4*)(p.rope_cos + pr * 64 + ch * 8 + 4);
      float4 s0 = *(const float4*)(p.rope_sin + pr * 64 + ch * 8), s1 = *(const float4*)(p.rope_sin + pr * 64 + ch * 8 + 4);
      cs[0] = c0.x; cs[1] = c0.y; cs[2] = c0.z; cs[3] = c0.w; cs[4] = c1.x; cs[5] = c1.y; cs[6] = c1.z; cs[7] = c1.w;
      sn[0] = s0.x; sn[1] = s0.y; sn[2] = s0.z; sn[3] = s0.w; sn[4] = s1.x; sn[5] = s1.y; sn[6] = s1.z; sn[7] = s1.w;
    }
    u16* rowp = p.Hb + (size_t)(tok0 + j) * 3072;
    {
      u16* qp = rowp + 1024 + h * 128 + ch * 8;
      uint4 a = *(const uint4*)qp, bb = *(const uint4*)(qp + 64);
      float x1[8], x2[8], o1[8], o2[8];
      unpack8(a, x1); unpack8(bb, x2);
#pragma unroll
      for (int e = 0; e < 8; e++) { o1[e] = x1[e] * cs[e] - x2[e] * sn[e]; o2[e] = x1[e] * sn[e] + x2[e] * cs[e]; }
      u16* qo = p.QKR + (size_t)(tok0 + j) * 1024 + h * 128 + ch * 8;
      *(uint4*)qo = pack8(o1);
      *(uint4*)(qo + 64) = pack8(o2);
    }
    {
      u16* kp = rowp + 1536 + h * 128 + ch * 8;
      uint4 a = *(const uint4*)kp, bb = *(const uint4*)(kp + 64);
      float x1[8], x2[8], o1[8], o2[8];
      unpack8(a, x1); unpack8(bb, x2);
      const float sc = 0.08838834764831845f;
#pragma unroll
      for (int e = 0; e < 8; e++) { o1[e] = (x1[e] * cs[e] - x2[e] * sn[e]) * sc; o2[e] = (x1[e] * sn[e] + x2[e] * cs[e]) * sc; }
      u16* ko = p.QKR + (size_t)(tok0 + j) * 1024 + 512 + h * 128 + ch * 8;
      *(uint4*)ko = pack8(o1);
      *(uint4*)(ko + 64) = pack8(o2);
      float dec = __expf(lg * (float)(127 - j));
#pragma unroll
      for (int e = 0; e < 8; e++) { o1[e] *= dec; o2[e] *= dec; }
      *(uint4*)(KL + j * 272 + ch * 16) = pack8(o1);
      *(uint4*)(KL + j * 272 + (ch + 8) * 16) = pack8(o2);
    }
  }
#pragma unroll
  for (int i = 0; i < 4; i++) {
    int q = tid + i * 512, j = q >> 4, c = q & 15;
    *(uint4*)(VL + j * 272 + c * 16) = *(const uint4*)(p.Hb + (size_t)(tok0 + j) * 3072 + 2048 + h * 128 + c * 8);
  }
  __syncthreads();
  f32x4 acc[8];
#pragma unroll
  for (int i = 0; i < 8; i++) acc[i] = (f32x4){0.f, 0.f, 0.f, 0.f};
#pragma unroll
  for (int ks = 0; ks < 4; ks++) {
    bf16x8 af = tr_frag(VL, 272, 32 * ks, 16 * wid, lane);
#pragma unroll
    for (int dt = 0; dt < 8; dt++) {
      bf16x8 bk = tr_frag(KL, 272, 32 * ks, 16 * dt, lane);
      acc[dt] = mfma16(af, bk, acc[dt]);
    }
  }
  float* U = p.U + (size_t)id * 16384;
#pragma unroll
  for (int dt = 0; dt < 8; dt++)
#pragma unroll
    for (int r = 0; r < 4; r++) U[(16 * wid + 4 * g4 + r) * 128 + 16 * dt + l15] = acc[dt][r];
  __syncthreads();
}

DEVINL void ret_sample_item(const Params& p, int id, char* smem) {
  const int tid = get_tid(), lane = tid & 63, wid = tid >> 6;
  const int b = id >> 2, h = id & 3;
  float* qf = (float*)smem;
  float* kf = qf + 1024;
  float* kd = kf + 1024;
  float* vf = kd + 1024;
  float* PL = vf + 1024;
  float* red = PL + 64;
  const float lg = logf(1.0f - exp2f(-5.0f - (float)h));
  {
    int i = tid >> 6, dp = tid & 63;
    int tok = T_P + b * 8 + i, pr = 2048 + i;
    float c = p.rope_cos[pr * 64 + dp], s = p.rope_sin[pr * 64 + dp];
    const u16* rowp = p.Hb + (size_t)tok * 3072;
    float q1 = bf1(rowp[1024 + h * 128 + dp]), q2 = bf1(rowp[1024 + h * 128 + 64 + dp]);
    qf[i * 128 + dp] = q1 * c - q2 * s;
    qf[i * 128 + 64 + dp] = q1 * s + q2 * c;
    const float sc = 0.08838834764831845f;
    float k1 = bf1(rowp[1536 + h * 128 + dp]), k2 = bf1(rowp[1536 + h * 128 + 64 + dp]);
    float ka = (k1 * c - k2 * s) * sc, kb = (k1 * s + k2 * c) * sc;
    kf[i * 128 + dp] = ka; kf[i * 128 + 64 + dp] = kb;
    float dec = __expf(lg * (float)(7 - i));
    kd[i * 128 + dp] = ka * dec; kd[i * 128 + 64 + dp] = kb * dec;
    vf[i * 128 + dp] = bf1(rowp[2048 + h * 128 + dp]);
    vf[i * 128 + 64 + dp] = bf1(rowp[2048 + h * 128 + 64 + dp]);
  }
  __syncthreads();
  if (tid < 64) {
    int i = tid >> 3, j = tid & 7;
    float s = 0.f;
    if (j <= i) {
      for (int d = 0; d < 128; d++) s += qf[i * 128 + d] * kf[j * 128 + d];
      s *= __expf(lg * (float)(i - j));
    }
    PL[tid] = s;
  }
  {
    int e = tid & 127, dq = tid >> 7;
    const float* S0 = p.state_ret + (size_t)(b * 4 + h) * 16384;
    float* Sn = p.new_ret_sample + (size_t)(b * 4 + h) * 16384;
    float part[8], vv[8];
#pragma unroll
    for (int i = 0; i < 8; i++) { part[i] = 0.f; vv[i] = vf[i * 128 + e]; }
    const float c8 = __expf(lg * 8.0f);
    float s0v[32];
#pragma unroll
    for (int dd = 0; dd < 32; dd++) s0v[dd] = S0[(dq * 32 + dd) * 128 + e];
#pragma unroll
    for (int dd = 0; dd < 32; dd++) {
      const int d = dq * 32 + dd;
      float s = s0v[dd];
      float sn = s * c8;
#pragma unroll
      for (int j = 0; j < 8; j++) sn += kd[j * 128 + d] * vv[j];
      Sn[d * 128 + e] = sn;
#pragma unroll
      for (int i = 0; i < 8; i++) part[i] += qf[i * 128 + d] * s;
    }
#pragma unroll
    for (int i = 0; i < 8; i++) red[(dq * 8 + i) * 128 + e] = part[i];
  }
  __syncthreads();
  {
    int i = wid;
    int tok = T_P + b * 8 + i;
    float qdec = __expf(lg * (float)(i + 1));
    float o[2];
#pragma unroll
    for (int hf = 0; hf < 2; hf++) {
      int e = lane + 64 * hf;
      float a = 0.f;
#pragma unroll
      for (int j = 0; j < 8; j++) a += PL[i * 8 + j] * vf[j * 128 + e];
      float r = red[(0 * 8 + i) * 128 + e] + red[(1 * 8 + i) * 128 + e] + red[(2 * 8 + i) * 128 + e] + red[(3 * 8 + i) * 128 + e];
      o[hf] = a + qdec * r;
    }
    float mean = wave_sum(o[0] + o[1]) * (1.0f / 128.0f);
    float d0 = o[0] - mean, d1 = o[1] - mean;
    float rstd = rsqrtf(wave_sum(d0 * d0 + d1 * d1) * (1.0f / 128.0f) + LN_EPS_F);
#pragma unroll
    for (int hf = 0; hf < 2; hf++) {
      int e = lane + 64 * hf;
      float on = (o[hf] - mean) * rstd * p.ret_gn_g[h * 128 + e] + p.ret_gn_b[h * 128 + e];
      float sg = bf1(p.Hb[(size_t)tok * 3072 + 2560 + h * 128 + e]);
      p.MIXIN[(size_t)tok * 1024 + 512 + h * 128 + e] = f2bf(sg * on);
    }
  }
  __syncthreads();
}

DEVINL void gate_sample_item(const Params& p, int b, char* smem) {
  const int tid = get_tid(), lane = tid & 63, wid = tid >> 6;
  float* VS = (float*)smem;
  {
    int s = wid, tok = T_P + b * 8 + s;
    uint4 raw = *(const uint4*)(p.Hb + (size_t)tok * 3072 + 512 + lane * 8);
    float x[8]; unpack8(raw, x);
    float sum = 0.f;
#pragma unroll
    for (int j = 0; j < 8; j++) sum += x[j];
    sum += __shfl_xor(sum, 1); sum += __shfl_xor(sum, 2); sum += __shfl_xor(sum, 4); sum += __shfl_xor(sum, 8);
    float mean = sum * (1.0f / 128.0f);
    float var = 0.f;
#pragma unroll
    for (int j = 0; j < 8; j++) { float d = x[j] - mean; var += d * d; }
    var += __shfl_xor(var, 1); var += __shfl_xor(var, 2); var += __shfl_xor(var, 4); var += __shfl_xor(var, 8);
    float rstd = rsqrtf(var * (1.0f / 128.0f) + LN_EPS_F);
#pragma unroll
    for (int j = 0; j < 8; j++) x[j] = (x[j] - mean) * rstd * p.gate_ln_g[lane * 8 + j] + p.gate_ln_b[lane * 8 + j];
    float* go = p.new_gate_v + (size_t)(b * 8 + s) * 512 + lane * 8;
    *(float4*)go = make_float4(x[0], x[1], x[2], x[3]);
    *(float4*)(go + 4) = make_float4(x[4], x[5], x[6], x[7]);
#pragma unroll
    for (int j = 0; j < 8; j++) VS[s * 512 + lane * 8 + j] = x[j];
  }
  __syncthreads();
  {
    int g = tid >> 7;
    float vs[8];
#pragma unroll
    for (int s = 0; s < 8; s++) vs[s] = VS[s * 512 + tid];
#pragma unroll
    for (int t = 0; t < 8; t++) {
      float mixed = p.b_s[g * 128 + t];
#pragma unroll
      for (int s = 0; s < 8; s++)
        if (s <= t) mixed += p.w_s[g * 16384 + t * 128 + s] * vs[s];
      int tok = T_P + b * 8 + t;
      float ua = bf1(p.Hb[(size_t)tok * 3072 + tid]);
      p.MIXIN[(size_t)tok * 1024 + tid] = f2bf(ua * mixed);
    }
  }
  __syncthreads();
}

DEVINL void ret_scan_item(const Params& p, int id) {
  const int tid = get_tid();
  const int bh = id >> 3, q = (id & 7) * 512 + tid, h = bh & 3;
  const float lg = logf(1.0f - exp2f(-5.0f - (float)h));
  const float c128 = __expf(lg * 128.0f);
  const float4* ub = (const float4*)(p.U + (size_t)(bh * 16) * 16384) + q;
  float4 u[16];
#pragma unroll
  for (int n = 0; n < 16; n++) u[n] = ub[(size_t)n * 4096];
  float4 sv = make_float4(0.f, 0.f, 0.f, 0.f);
  uint2* sp = (uint2*)(p.SP + (size_t)(bh * 16) * 16384) + q;
#pragma unroll
  for (int n = 0; n < 16; n++) {
    uint2 o; o.x = pk2(sv.x, sv.y); o.y = pk2(sv.z, sv.w);
    sp[(size_t)n * 4096] = o;
    sv.x = sv.x * c128 + u[n].x; sv.y = sv.y * c128 + u[n].y; sv.z = sv.z * c128 + u[n].z; sv.w = sv.w * c128 + u[n].w;
  }
  const int e = q >> 5, d4 = (q & 31) * 4;
  float* outp = p.new_ret_prompt + (size_t)bh * 16384;
  outp[(d4 + 0) * 128 + e] = sv.x;
  outp[(d4 + 1) * 128 + e] = sv.y;
  outp[(d4 + 2) * 128 + e] = sv.z;
  outp[(d4 + 3) * 128 + e] = sv.w;
}

DEVINL void r3_item(const Params& p, int id, char* smem) {
  const int tid = get_tid(), lane = tid & 63, wid = tid >> 6, l15 = lane & 15, g4 = lane >> 4;
  const int n = id < 256 ? 15 - (id >> 5) : ((id - 256) >> 5), bh = id & 31, b = bh >> 2, h = bh & 3;
  const int tok0 = b * 2048 + n * 128;
  char* KL = smem;
  char* VL = smem + 32768;
  char* STL = smem + 32768 + 34816;
  const float lg = logf(1.0f - exp2f(-5.0f - (float)h));
  const float c128 = __expf(lg * 128.0f);
#pragma unroll
  for (int i = 0; i < 4; i++) {
    int q = tid + i * 512, j = q >> 4, c = q & 15;
    const u16* rowp = p.Hb + (size_t)(tok0 + j) * 3072;
    *(uint4*)(KL + sw256(j, c)) = *(const uint4*)(p.QKR + (size_t)(tok0 + j) * 1024 + 512 + h * 128 + c * 8);
    *(uint4*)(VL + j * 272 + c * 16) = *(const uint4*)(rowp + 2048 + h * 128 + c * 8);
  }
  {
    const u16* spb = p.SP + (size_t)(bh * 16 + n) * 16384;
#pragma unroll
    for (int i = 0; i < 4; i++) {
      int q = tid + i * 512, e = q >> 4, c = q & 15;
      *(uint4*)(STL + sw256(e, c)) = *(const uint4*)(spb + e * 128 + c * 8);
    }
  }
  const int irow = 16 * wid + l15;
  const u16* qrow = p.Hb + (size_t)(tok0 + irow) * 3072;
  bf16x8 qf[4], qd[4];
  {
    const float qdec = __expf(lg * (float)(irow + 1));
#pragma unroll
    for (int ks = 0; ks < 4; ks++) {
      uint4 raw = *(const uint4*)(p.QKR + (size_t)(tok0 + irow) * 1024 + h * 128 + ks * 32 + 8 * g4);
      qf[ks] = as_frag(raw);
      float x[8]; unpack8(raw, x);
#pragma unroll
      for (int j = 0; j < 8; j++) x[j] *= qdec;
      qd[ks] = as_frag(pack8(x));
    }
  }
  __syncthreads();
  f32x4 pacc[8];
#pragma unroll
  for (int i = 0; i < 8; i++) pacc[i] = (f32x4){0.f, 0.f, 0.f, 0.f};
#pragma unroll
  for (int ks = 0; ks < 4; ks++) {
#pragma unroll
    for (int jt = 0; jt < 8; jt++) {
      if (jt <= wid) {
        bf16x8 kfr = lds_frag(KL + sw256(16 * jt + l15, ks * 4 + g4));
        pacc[jt] = mfma16(kfr, qf[ks], pacc[jt]);
      }
    }
  }
#pragma unroll
  for (int jt = 0; jt < 8; jt++)
#pragma unroll
    for (int r = 0; r < 4; r++) {
      int j = 16 * jt + 4 * g4 + r;
      float v = pacc[jt][r] * __expf(lg * (float)(irow - j));
      pacc[jt][r] = (j <= irow) ? v : 0.f;
    }
  bf16x8 pf[4];
#pragma unroll
  for (int s = 0; s < 4; s++) pf[s] = pack_frag(pacc[2 * s], pacc[2 * s + 1]);
  f32x4 oacc[8];
#pragma unroll
  for (int i = 0; i < 8; i++) oacc[i] = (f32x4){0.f, 0.f, 0.f, 0.f};
#pragma unroll
  for (int s = 0; s < 4; s++) {
    if (2 * s <= wid) {
#pragma unroll
      for (int et = 0; et < 8; et++) {
        bf16x8 vfr = tr_frag_perm(VL, 272, 32 * s, 16 * et, lane);
        oacc[et] = mfma16(vfr, pf[s], oacc[et]);
      }
    }
  }
#pragma unroll
  for (int ks = 0; ks < 4; ks++) {
#pragma unroll
    for (int et = 0; et < 8; et++) {
      bf16x8 sfr = lds_frag(STL + sw256(16 * et + l15, ks * 4 + g4));
      oacc[et] = mfma16(sfr, qd[ks], oacc[et]);
    }
  }
  float sum = 0.f;
#pragma unroll
  for (int et = 0; et < 8; et++) sum += oacc[et][0] + oacc[et][1] + oacc[et][2] + oacc[et][3];
  sum += __shfl_xor(sum, 16); sum += __shfl_xor(sum, 32);
  const float mean = sum * (1.0f / 128.0f);
  float var = 0.f;
#pragma unroll
  for (int et = 0; et < 8; et++)
#pragma unroll
    for (int r = 0; r < 4; r++) { float d = oacc[et][r] - mean; var += d * d; }
  var += __shfl_xor(var, 16); var += __shfl_xor(var, 32);
  const float rstd = rsqrtf(var * (1.0f / 128.0f) + LN_EPS_F);
#pragma unroll
  for (int et = 0; et < 8; et++) {
    int e = 16 * et + 4 * g4;
    float4 gg = *(const float4*)(p.ret_gn_g + h * 128 + e), gb = *(const float4*)(p.ret_gn_b + h * 128 + e);
    uint2 sg = *(const uint2*)(qrow + 2560 + h * 128 + e);
    float o0 = ((oacc[et][0] - mean) * rstd * gg.x + gb.x) * bflo(sg.x);
    float o1 = ((oacc[et][1] - mean) * rstd * gg.y + gb.y) * bfhi(sg.x);
    float o2 = ((oacc[et][2] - mean) * rstd * gg.z + gb.z) * bflo(sg.y);
    float o3 = ((oacc[et][3] - mean) * rstd * gg.w + gb.w) * bfhi(sg.y);
    uint2 o; o.x = pk2(o0, o1); o.y = pk2(o2, o3);
    *(uint2*)(p.MIXIN + (size_t)(tok0 + irow) * 1024 + 512 + h * 128 + e) = o;
  }
  __syncthreads();
}

DEVINL void attn_item(const Params& p, int id, char* smem) {
  const int tid = get_tid(), lane = tid & 63, wid = tid >> 6, l15 = lane & 15, g4 = lane >> 4;
  const bool sample = id >= 512;
  int b, h, tokbase, nvalid;
  if (!sample) { b = id >> 6; h = (id >> 4) & 3; tokbase = b * 2048 + (id & 15) * 128; nvalid = 128; }
  else { int s = id - 512; b = s >> 2; h = s & 3; tokbase = T_P + b * 8; nvalid = 8; }
  if (!sample) {
#pragma unroll 4
    for (int i = 0; i < 16; i++) {
      int q = tid + i * 512, r = q >> 5, c = q & 31;
      *(uint4*)(smem + sw512(r, c)) = *(const uint4*)(p.MemKVb + (size_t)(b * 256 + r) * 2048 + h * 256 + c * 8);
    }
  } else {
#pragma unroll 4
    for (int i = 0; i < 16; i++) {
      int q = tid + i * 512, r = q >> 5, c = q & 31;
      const float* src = p.cache_k + ((size_t)(b * 256 + r) * 4 + h) * 256 + c * 8;
      float4 a = *(const float4*)src, bb = *(const float4*)(src + 4);
      uint4 o; o.x = pk2(a.x, a.y); o.y = pk2(a.z, a.w); o.z = pk2(bb.x, bb.y); o.w = pk2(bb.z, bb.w);
      *(uint4*)(smem + sw512(r, c)) = o;
    }
  }
  __syncthreads();
  const bool active = wid * 16 < nvalid;
  const int irow = wid * 16 + l15;
  const int irc = irow < nvalid ? irow : nvalid - 1;
  const size_t tok = (size_t)(tokbase + irc);
  bf16x8 pf[8];
  float inv_sum = 0.f;
  if (active) {
    const u16* qp = p.QC + tok * 1024 + h * 256 + 8 * g4;
    f32x4 sacc[16];
#pragma unroll
    for (int i = 0; i < 16; i++) sacc[i] = (f32x4){0.f, 0.f, 0.f, 0.f};
    uint4 qcur = *(const uint4*)qp;
#pragma unroll 1
    for (int ks = 0; ks < 8; ks++) {
      uint4 qnext = *(const uint4*)(qp + (ks < 7 ? (ks + 1) * 32 : 0));
      bf16x8 qfr = as_frag(qcur);
#pragma unroll
      for (int mt = 0; mt < 16; mt++) {
        bf16x8 kfr = lds_frag(smem + sw512(16 * mt + l15, ks * 4 + g4));
        sacc[mt] = mfma16(kfr, qfr, sacc[mt]);
      }
      qcur = qnext;
    }
    float mx = -3.0e38f;
#pragma unroll
    for (int mt = 0; mt < 16; mt++)
#pragma unroll
      for (int r = 0; r < 4; r++) mx = fmaxf(mx, sacc[mt][r]);
    mx = fmaxf(mx, __shfl_xor(mx, 16)); mx = fmaxf(mx, __shfl_xor(mx, 32));
    float sum = 0.f;
#pragma unroll
    for (int mt = 0; mt < 16; mt++)
#pragma unroll
      for (int r = 0; r < 4; r++) { float e = __expf(sacc[mt][r] - mx); sacc[mt][r] = e; sum += e; }
    sum += __shfl_xor(sum, 16); sum += __shfl_xor(sum, 32);
    inv_sum = 1.0f / sum;
#pragma unroll
    for (int s = 0; s < 8; s++) pf[s] = pack_frag(sacc[2 * s], sacc[2 * s + 1]);
  }
  __syncthreads();
  if (!sample) {
#pragma unroll 4
    for (int i = 0; i < 16; i++) {
      int q = tid + i * 512, r = q >> 5, c = q & 31;
      *(uint4*)(smem + r * 528 + c * 16) = *(const uint4*)(p.MemKVb + (size_t)(b * 256 + r) * 2048 + 1024 + h * 256 + c * 8);
    }
  } else {
#pragma unroll 4
    for (int i = 0; i < 16; i++) {
      int q = tid + i * 512, r = q >> 5, c = q & 31;
      const float* src = p.cache_v + ((size_t)(b * 256 + r) * 4 + h) * 256 + c * 8;
      float4 a = *(const float4*)src, bb = *(const float4*)(src + 4);
      uint4 o; o.x = pk2(a.x, a.y); o.y = pk2(a.z, a.w); o.z = pk2(bb.x, bb.y); o.w = pk2(bb.z, bb.w);
      *(uint4*)(smem + r * 528 + c * 16) = o;
    }
  }
  __syncthreads();
  if (active) {
    f32x4 oacc[16];
#pragma unroll
    for (int i = 0; i < 16; i++) oacc[i] = (f32x4){0.f, 0.f, 0.f, 0.f};
#pragma unroll
    for (int s = 0; s < 8; s++) {
#pragma unroll
      for (int dt = 0; dt < 16; dt++) {
        bf16x8 vfr = tr_frag_perm(smem, 528, 32 * s, 16 * dt, lane);
        oacc[dt] = mfma16(vfr, pf[s], oacc[dt]);
      }
    }
    if (irow < nvalid) {
#pragma unroll
      for (int dt = 0; dt < 16; dt++) {
        int d = 16 * dt + 4 * g4;
        uint2 o; o.x = pk2(oacc[dt][0] * inv_sum, oacc[dt][1] * inv_sum); o.y = pk2(oacc[dt][2] * inv_sum, oacc[dt][3] * inv_sum);
        *(uint2*)(p.CA + tok * 1024 + h * 256 + d) = o;
      }
    }
  }
  __syncthreads();
}

DEVINL int mono(float f) { int b = __float_as_int(f); return b ^ ((b >> 31) & 0x7fffffff); }
DEVINL float unmono(int k) { return __int_as_float(k ^ ((k >> 31) & 0x7fffffff)); }
#define INS16(top, xv) { int _x = (xv); _Pragma("unroll") for (int _k = 0; _k < 16; _k++) { int _h = max(top[_k], _x); _x = min(top[_k], _x); top[_k] = _h; } }

struct CandTab { int a[64], b[64]; };
constexpr CandTab make_cand_tab() {
  CandTab t{};
  int sl = 0;
  for (int a = 0; a < 16; a++)
    for (int bb = 0; bb < 16; bb++)
      if ((a + 1) * (bb + 1) <= 16) { t.a[sl] = a; t.b[sl] = bb; sl++; }
  for (; sl < 64; sl++) { t.a[sl] = -1; t.b[sl] = -1; }
  return t;
}
constexpr CandTab CT = make_cand_tab();

#define CEX(a, b) { int _mx = max(a, b); int _mn = min(a, b); a = _mx; b = _mn; }
DEVINL void sort16_desc(int (&v)[16]) {
#pragma unroll
  for (int k = 2; k <= 16; k <<= 1) {
#pragma unroll
    for (int j = k >> 1; j > 0; j >>= 1) {
#pragma unroll
      for (int i = 0; i < 16; i++) {
        const int l = i ^ j;
        if (l > i) {
          if ((i & k) == 0) { CEX(v[i], v[l]); } else { CEX(v[l], v[i]); }
        }
      }
    }
  }
}
DEVINL void merge16_desc(int (&a)[16], const int (&b)[16]) {
#pragma unroll
  for (int i = 0; i < 16; i++) a[i] = max(a[i], b[15 - i]);
#pragma unroll
  for (int j = 8; j > 0; j >>= 1) {
#pragma unroll
    for (int i = 0; i < 16; i++) {
      const int l = i ^ j;
      if (l > i) { CEX(a[i], a[l]); }
    }
  }
}

DEVINL void topk_load_q(const Params& p, int t, int wid, int l15, int g4, uint4 (&q)[8]) {
  const int tile = t >> 3, h = t & 7;
  const u16* qp = p.PQ + (size_t)(tile * 128 + 16 * wid + l15) * 2048 + h * 256 + 8 * g4;
#pragma unroll
  for (int c = 0; c < 2; c++)
#pragma unroll
    for (int ks = 0; ks < 4; ks++) q[c * 4 + ks] = *(const uint4*)(qp + c * 128 + ks * 32);
}
DEVINL void topk_half(const float* SCw, int tk, int qt, int (&top)[16]) {
  const float* sp = SCw + (size_t)tk * 132 + qt * 32;
#pragma unroll
  for (int grp = 0; grp < 2; grp++) {
    int v[16];
#pragma unroll
    for (int i = 0; i < 4; i++) {
      f32x4 x = *(const f32x4*)(sp + grp * 16 + i * 4);
#pragma unroll
      for (int r = 0; r < 4; r++) {
        int kidx = qt * 32 + grp * 16 + i * 4 + r;
        v[i * 4 + r] = (mono(x[r]) & ~0x7F) | (127 - kidx);
      }
    }
    sort16_desc(v);
    if (grp == 0) {
#pragma unroll
      for (int k = 0; k < 16; k++) top[k] = v[k];
    } else {
      merge16_desc(top, v);
    }
  }
  int b[16];
#pragma unroll
  for (int k = 0; k < 16; k++) b[k] = __shfl_xor(top[k], 16);
  merge16_desc(top, b);
#pragma unroll
  for (int k = 0; k < 16; k++) b[k] = __shfl_xor(top[k], 32);
  merge16_desc(top, b);
}
DEVINL void peer_topk_phase(const Params& p, char* smem) {
  const int tid = get_tid(), lane = tid & 63, wid = __builtin_amdgcn_readfirstlane(tid >> 6), l15 = lane & 15, g4 = lane >> 4;
  const int bid = blockIdx.x, nb = gridDim.x;
  char* SK = smem;
  float* SCw = (float*)(smem + 65536 + wid * 8448);
  int* LI = (int*)SCw;
  int h_loaded = -1;
  uint4 qn[8];
  if (bid < 1088) topk_load_q(p, bid, wid, l15, g4, qn);
  for (int t = bid; t < 1088; t += nb) {
    const int tile = t >> 3, h = t & 7;
    if (h != h_loaded) {
      __syncthreads();
#pragma unroll
      for (int i = 0; i < 8; i++) {
        int q = tid + i * 512, r = q >> 4, c = q & 15;
        *(uint4*)(SK + sw256(r, c)) = *(const uint4*)(p.SubK + (size_t)(h * 256 + r) * 128 + c * 8);
      }
      __syncthreads();
      h_loaded = h;
    }
    uint4 qc[8];
#pragma unroll
    for (int i = 0; i < 8; i++) qc[i] = qn[i];
    if (t + nb < 1088) topk_load_q(p, t + nb, wid, l15, g4, qn);
    const int tok0 = tile * 128 + 16 * wid;
    const int tk = lane & 15, qt = lane >> 4;
    int m0[16], m1[16];
#pragma unroll
    for (int c = 0; c < 2; c++) {
      f32x4 acc[8];
#pragma unroll
      for (int i = 0; i < 8; i++) acc[i] = (f32x4){0.f, 0.f, 0.f, 0.f};
#pragma unroll
      for (int ks = 0; ks < 4; ks++) {
        bf16x8 qfr = as_frag(qc[c * 4 + ks]);
#pragma unroll
        for (int kt = 0; kt < 8; kt++) {
          bf16x8 kfr = lds_frag(SK + sw256(c * 128 + 16 * kt + l15, ks * 4 + g4));
          acc[kt] = mfma16(kfr, qfr, acc[kt]);
        }
      }
      __builtin_amdgcn_wave_barrier();
#pragma unroll
      for (int kt = 0; kt < 8; kt++) *(f32x4*)(SCw + (size_t)l15 * 132 + 16 * kt + 4 * g4) = acc[kt];
      __builtin_amdgcn_wave_barrier();
      if (c == 0) topk_half(SCw, tk, qt, m0); else topk_half(SCw, tk, qt, m1);
      __builtin_amdgcn_wave_barrier();
    }
    if (qt < 2) {
      int* dst = LI + (qt * 16 + tk) * 17;
#pragma unroll
      for (int k = 0; k < 16; k++) dst[k] = qt ? m1[k] : m0[k];
    }
    int top[16];
    {
      float v0[16], v1[16];
#pragma unroll
      for (int k = 0; k < 16; k++) { v0[k] = unmono(m0[k] & ~0x7F); v1[k] = unmono(m1[k] & ~0x7F); }
#pragma unroll
      for (int k = 0; k < 16; k++) {
        int key[4];
#pragma unroll
        for (int g = 0; g < 4; g++) {
          const int ca = CT.a[g * 16 + k], cb = CT.b[g * 16 + k];
          if (ca >= 0) {
            float sm = v0[ca] + v1[cb];
            key[g] = (mono(sm) & ~0xFF) | (255 - (ca * 16 + cb));
          } else {
            key[g] = (int)0x80000000;
          }
        }
        int lo = (qt & 1) ? key[1] : key[0];
        int hi = (qt & 1) ? key[3] : key[2];
        top[k] = (qt & 2) ? hi : lo;
      }
      sort16_desc(top);
      int b[16];
#pragma unroll
      for (int k = 0; k < 16; k++) b[k] = __shfl_xor(top[k], 16);
      merge16_desc(top, b);
#pragma unroll
      for (int k = 0; k < 16; k++) b[k] = __shfl_xor(top[k], 32);
      merge16_desc(top, b);
    }
    __builtin_amdgcn_wave_barrier();
    if (qt == 0) {
      const int* l0 = LI + (0 * 16 + tk) * 17;
      const int* l1 = LI + (1 * 16 + tk) * 17;
      float fv[16];
      float sum = 0.f;
      const float mx = unmono(top[0] & ~0xFF);
#pragma unroll
      for (int k = 0; k < 16; k++) { fv[k] = __expf(unmono(top[k] & ~0xFF) - mx); sum += fv[k]; }
      const float inv = 1.0f / sum;
      const size_t ob = ((size_t)(tok0 + tk) * 8 + h) * 16;
#pragma unroll
      for (int k = 0; k < 16; k++) {
        int code = 255 - (top[k] & 0xFF);
        int a = code >> 4, bb = code & 15;
        int i0 = 127 - (l0[a] & 0x7F), i1 = 127 - (l1[bb] & 0x7F);
        p.SELI[ob + k] = i0 * 128 + i1;
        p.SELG[ob + k] = fv[k] * inv;
      }
    }
    __builtin_amdgcn_wave_barrier();
  }
}

typedef float f32x2 __attribute__((ext_vector_type(2)));
#define DEC16(q, f) { f32x2 t_; \
  t_ = __builtin_amdgcn_cvt_pk_f32_fp8((int)(q).x, false); f[0] = t_[0]; f[1] = t_[1]; t_ = __builtin_amdgcn_cvt_pk_f32_fp8((int)(q).x, true); f[2] = t_[0]; f[3] = t_[1]; \
  t_ = __builtin_amdgcn_cvt_pk_f32_fp8((int)(q).y, false); f[4] = t_[0]; f[5] = t_[1]; t_ = __builtin_amdgcn_cvt_pk_f32_fp8((int)(q).y, true); f[6] = t_[0]; f[7] = t_[1]; \
  t_ = __builtin_amdgcn_cvt_pk_f32_fp8((int)(q).z, false); f[8] = t_[0]; f[9] = t_[1]; t_ = __builtin_amdgcn_cvt_pk_f32_fp8((int)(q).z, true); f[10] = t_[0]; f[11] = t_[1]; \
  t_ = __builtin_amdgcn_cvt_pk_f32_fp8((int)(q).w, false); f[12] = t_[0]; f[13] = t_[1]; t_ = __builtin_amdgcn_cvt_pk_f32_fp8((int)(q).w, true); f[14] = t_[0]; f[15] = t_[1]; }

#ifndef NFP8
#define NFP8 4
#endif
DEVINL void peer_gather_phase(const Params& p) {
  const int tid_ = get_tid(); const int lane = tid_ & 63, wid = __builtin_amdgcn_readfirstlane(tid_ >> 6);
  const int kl = ((lane >> 5) & 1) * 8 + ((lane >> 4) & 1) * 4 + ((lane >> 3) & 1) * 2 + ((lane >> 2) & 1);
  for (int t = blockIdx.x * 8 + wid; t < T_ALL; t += gridDim.x * 8) {
    float x[16], out[16];
    {
      const u16* xr = p.Xb + (size_t)t * 1024 + lane * 16;
      uint4 a = *(const uint4*)xr, b = *(const uint4*)(xr + 8);
      unpack8(a, x); unpack8(b, x + 8);
    }
    float out4[16];
    float sumck = 0.f;
#pragma unroll
    for (int j = 0; j < 16; j++) { out[j] = 0.f; out4[j] = 0.f; }
    int xp[2][2];
    float xs;
    {
      float am = 0.f;
#pragma unroll
      for (int j = 0; j < 16; j++) am = fmaxf(am, fabsf(x[j]));
#pragma unroll
      for (int o = 32; o >= 1; o >>= 1) am = fmaxf(am, __shfl_xor(am, o));
      const float xinv = am > 0.f ? 118.0f / am : 0.f;
      xs = am > 0.f ? am / 118.0f : 0.f;
      unsigned pl[2][2] = {{0u, 0u}, {0u, 0u}};
#pragma unroll
      for (int j = 0; j < 16; j++) {
        const int xi = (int)rintf(x[j] * xinv);
        const int n0 = ((xi + 8) & 15) - 8;
        const int n1 = (xi - n0) >> 4;
        pl[0][j >> 3] |= ((unsigned)n0 & 15u) << (4 * (j & 7));
        pl[1][j >> 3] |= ((unsigned)n1 & 15u) << (4 * (j & 7));
      }
#pragma unroll
      for (int q = 0; q < 2; q++) { xp[q][0] = (int)pl[q][0]; xp[q][1] = (int)pl[q][1]; }
    }
#pragma unroll 1
    for (int h = 0; h < 8; h++) {
      const size_t sb = ((size_t)t * 8 + h) * 16;
      const int ei = p.SELI[sb + (lane & 15)];
      const int ekl = p.SELI[sb + kl];
      const float gk = p.SELG[sb + kl];
      const float us = p.Usc[ekl] * xs, vs = (kl >= NFP8) ? p.Vsc4[ekl] : p.Vsc[ekl];
      float part[16];
      {
        uint2 u[16];
#pragma unroll
        for (int k = 0; k < 16; k++) {
          int e = __builtin_amdgcn_readlane(ei, k);
          u[k] = *(const uint2*)(p.Ub4 + (size_t)e * 512 + lane * 8);
        }
#pragma unroll
        for (int k = 0; k < 16; k++) {
          const int d0 = __builtin_amdgcn_sdot8((int)u[k].x, xp[0][0], __builtin_amdgcn_sdot8((int)u[k].y, xp[0][1], 0, false), false);
          const int d1 = __builtin_amdgcn_sdot8((int)u[k].x, xp[1][0], __builtin_amdgcn_sdot8((int)u[k].y, xp[1][1], 0, false), false);
          part[k] = (float)(d0 + 16 * d1);
        }
      }
      float p8[8], p4[4], p2[2], z;
      {
        const bool hi = (lane & 32) != 0;
#pragma unroll
        for (int k = 0; k < 8; k++) {
          float send = hi ? part[k] : part[k + 8];
          float keep = hi ? part[k + 8] : part[k];
          p8[k] = keep + __shfl_xor(send, 32);
        }
      }
      {
        const bool hi = (lane & 16) != 0;
#pragma unroll
        for (int k = 0; k < 4; k++) {
          float send = hi ? p8[k] : p8[k + 4];
          float keep = hi ? p8[k + 4] : p8[k];
          p4[k] = keep + __shfl_xor(send, 16);
        }
      }
      {
        const bool hi = (lane & 8) != 0;
#pragma unroll
        for (int k = 0; k < 2; k++) {
          float send = hi ? p4[k] : p4[k + 2];
          float keep = hi ? p4[k + 2] : p4[k];
          p2[k] = keep + __shfl_xor(send, 8);
        }
      }
      {
        const bool hi = (lane & 4) != 0;
        float send = hi ? p2[0] : p2[1];
        float keep = hi ? p2[1] : p2[0];
        z = keep + __shfl_xor(send, 4);
      }
      z += __shfl_xor(z, 1);
      z += __shfl_xor(z, 2);
      const float co = gk * gelu_tanh(z * us) * vs;
      {
        uint4 v[NFP8];
#pragma unroll
        for (int k = 0; k < NFP8; k++) {
          int e = __builtin_amdgcn_readlane(ei, k);
          v[k] = *(const uint4*)(p.Vb8 + (size_t)e * 1024 + lane * 16);
        }
#pragma unroll
        for (int k = 0; k < NFP8; k++) {
          const int src = ((k >> 3) & 1) * 32 + ((k >> 2) & 1) * 16 + ((k >> 1) & 1) * 8 + (k & 1) * 4;
          const float ck = __int_as_float(__builtin_amdgcn_readlane(__float_as_int(co), src));
          float f[16];
          DEC16(v[k], f);
#pragma unroll
          for (int j = 0; j < 16; j++) out[j] += ck * f[j];
        }
        __builtin_amdgcn_sched_barrier(0);
      }
      {
        uint2 v[16 - NFP8];
#pragma unroll
        for (int k = 0; k < 16 - NFP8; k++) {
          int e = __builtin_amdgcn_readlane(ei, NFP8 + k);
          v[k] = *(const uint2*)(p.Vb4 + (size_t)e * 512 + lane * 8);
        }
#pragma unroll
        for (int k = 0; k < 16 - NFP8; k++) {
          const int kk = NFP8 + k;
          const int src = ((kk >> 3) & 1) * 32 + ((kk >> 2) & 1) * 16 + ((kk >> 1) & 1) * 8 + (kk & 1) * 4;
          const float ck = __int_as_float(__builtin_amdgcn_readlane(__float_as_int(co), src));
          const unsigned ckb = pk2(ck, 0.f) & 0xffffu;
          union { unsigned u; bf16v2 h; } blo, bhi, tt;
          blo.u = ckb; bhi.u = ckb << 16;
          sumck += __uint_as_float(ckb << 16);
#pragma unroll
          for (int w = 0; w < 2; w++) {
            const unsigned wd = w ? v[k].y : v[k].x;
#pragma unroll
            for (int i = 0; i < 4; i++) {
              tt.u = ((wd >> (4 * i)) & 0x000F000Fu) | 0x43004300u;
              out4[8 * w + i] = __builtin_amdgcn_fdot2_f32_bf16(tt.h, blo.h, out4[8 * w + i], false);
              out4[8 * w + i + 4] = __builtin_amdgcn_fdot2_f32_bf16(tt.h, bhi.h, out4[8 * w + i + 4], false);
            }
          }
        }
        __builtin_amdgcn_sched_barrier(0);
      }
    }
#pragma unroll
    for (int j = 0; j < 16; j++) out[j] += out4[j] - 136.0f * sumck;
    float s = 0.f;
#pragma unroll
    for (int j = 0; j < 16; j++) { out[j] = ALPHA_F * x[j] + out[j]; s += out[j]; }
    const float mean = wave_sum(s) * (1.0f / 1024.0f);
    float q = 0.f;
#pragma unroll
    for (int j = 0; j < 16; j++) { float d = out[j] - mean; q += d * d; }
    const float rstd = rsqrtf(wave_sum(q) * (1.0f / 1024.0f) + LN_EPS_F);
    float* yr = p.Y + (size_t)t * 1024 + lane * 16;
    const float* gp = p.ln3_g + lane * 16;
    const float* bp = p.ln3_b + lane * 16;
#pragma unroll
    for (int i = 0; i < 4; i++) {
      float4 g = *(const float4*)(gp + i * 4), b = *(const float4*)(bp + i * 4);
      float4 y;
      y.x = (out[i * 4 + 0] - mean) * rstd * g.x + b.x; y.y = (out[i * 4 + 1] - mean) * rstd * g.y + b.y;
      y.z = (out[i * 4 + 2] - mean) * rstd * g.z + b.z; y.w = (out[i * 4 + 3] - mean) * rstd * g.w + b.w;
      *(float4*)(yr + i * 4) = y;
    }
  }
}

struct KArgs { const float* in[28]; float* out; char* ws; int flags; int pad; };

constexpr size_t al256(size_t b) { return (b + 255) & ~(size_t)255; }
constexpr size_t OFF_BAR = 0;
constexpr size_t OFF_WINT = OFF_BAR + 16384;
constexpr size_t OFF_WOT = OFF_WINT + al256((size_t)3072 * 1024 * 2);
constexpr size_t OFF_WQT = OFF_WOT + al256((size_t)1024 * 1024 * 2);
constexpr size_t OFF_WKVT = OFF_WQT + al256((size_t)1024 * 1024 * 2);
constexpr size_t OFF_WCOT = OFF_WKVT + al256((size_t)2048 * 1024 * 2);
constexpr size_t OFF_PWQT = OFF_WCOT + al256((size_t)1024 * 1024 * 2);
constexpr size_t OFF_SUBK = OFF_PWQT + al256((size_t)2048 * 1024 * 2);
constexpr size_t OFF_UB = OFF_SUBK + al256((size_t)262144 * 2);
constexpr size_t OFF_VB = OFF_UB + al256((size_t)16384 * 1024 * 2);
constexpr size_t OFF_XB = OFF_VB + al256((size_t)16384 * 1024 * 2);
constexpr size_t OFF_MEMB = OFF_XB + al256((size_t)T_ALL * 1024 * 2);
constexpr size_t OFF_HB = OFF_MEMB + al256((size_t)2048 * 1024 * 2);
constexpr size_t OFF_MEMKVB = OFF_HB + al256((size_t)T_ALL * 3072 * 2);
constexpr size_t OFF_RCOS = OFF_MEMKVB + al256((size_t)2048 * 2048 * 2);
constexpr size_t OFF_RSIN = OFF_RCOS + al256((size_t)2056 * 64 * 4);
constexpr size_t OFF_U = OFF_RSIN + al256((size_t)2056 * 64 * 4);
constexpr size_t OFF_MIXIN = OFF_U + al256((size_t)512 * 16384 * 4);
constexpr size_t OFF_PRE = OFF_MIXIN + al256((size_t)T_ALL * 1024 * 2);
constexpr size_t OFF_XF = OFF_PRE + al256((size_t)T_ALL * 1024 * 4);
constexpr size_t OFF_SELI = OFF_XF + al256((size_t)T_ALL * 1024 * 4);
constexpr size_t OFF_SELG = OFF_SELI + al256((size_t)T_ALL * 128 * 4);
constexpr size_t OFF_QKR = OFF_SELG + al256((size_t)T_ALL * 128 * 4);
constexpr size_t WS_TOTAL = OFF_QKR + al256((size_t)T_P * 1024 * 2);

DEVINL Params make_view(const KArgs& ka) {
  Params p;
  p.x_prompt = ka.in[0]; p.x_sample = ka.in[1]; p.mem_prompt = ka.in[2]; p.cache_k = ka.in[3]; p.cache_v = ka.in[4]; p.state_ret = ka.in[5];
  p.w_in = ka.in[6]; p.w_s = ka.in[7]; p.b_s = ka.in[8]; p.gate_ln_g = ka.in[9]; p.gate_ln_b = ka.in[10]; p.ret_gn_g = ka.in[11];
  p.ret_gn_b = ka.in[12]; p.w_o = ka.in[13]; p.ln1_g = ka.in[14]; p.ln1_b = ka.in[15]; p.ca_wq = ka.in[16]; p.ca_wk = ka.in[17];
  p.ca_wv = ka.in[18]; p.ca_wo = ka.in[19]; p.ln2_g = ka.in[20]; p.ln2_b = ka.in[21]; p.peer_wq = ka.in[22]; p.peer_subkeys = ka.in[23];
  p.peer_u = ka.in[24]; p.peer_v = ka.in[25]; p.ln3_g = ka.in[26]; p.ln3_b = ka.in[27];
  float* o = ka.out;
  p.Y = o;
  p.new_mem_k = o + (size_t)T_ALL * 1024;
  p.new_mem_v = p.new_mem_k + (size_t)2048 * 1024;
  p.new_ret_prompt = p.new_mem_v + (size_t)2048 * 1024;
  p.new_ret_sample = p.new_ret_prompt + (size_t)32 * 16384;
  p.new_gate_v = p.new_ret_sample + (size_t)512 * 16384;
  char* w = ka.ws;
  p.bar = (unsigned*)(w + OFF_BAR);
  p.WinT = (u16*)(w + OFF_WINT); p.WoT = (u16*)(w + OFF_WOT); p.WqT = (u16*)(w + OFF_WQT); p.WkvT = (u16*)(w + OFF_WKVT);
  p.WcoT = (u16*)(w + OFF_WCOT); p.PwqT = (u16*)(w + OFF_PWQT); p.SubK = (u16*)(w + OFF_SUBK); p.Ub = (u16*)(w + OFF_UB);
  p.Vb = (u16*)(w + OFF_VB);
  p.Ub8 = (unsigned char*)(w + OFF_UB); p.Ub4 = p.Ub8; p.Usc = (float*)(w + OFF_UB + (size_t)16384 * 1024);
  p.Vb8 = (unsigned char*)(w + OFF_VB); p.Vsc = (float*)(w + OFF_VB + (size_t)16384 * 1024);
  p.Vb4 = (unsigned char*)(w + OFF_VB + (size_t)20 * 1024 * 1024); p.Vsc4 = (float*)(w + OFF_VB + (size_t)30 * 1024 * 1024); p.Xb = (u16*)(w + OFF_XB); p.Memb = (u16*)(w + OFF_MEMB); p.Hb = (u16*)(w + OFF_HB);
  p.QC = p.Hb; p.PQ = p.Hb + (size_t)T_ALL * 1024;
  p.MemKVb = (u16*)(w + OFF_MEMKVB); p.rope_cos = (float*)(w + OFF_RCOS); p.rope_sin = (float*)(w + OFF_RSIN);
  p.U = (float*)(w + OFF_U); p.MIXIN = (u16*)(w + OFF_MIXIN); p.CA = p.MIXIN; p.PREb = (u16*)(w + OFF_PRE); p.SP = (u16*)(w + OFF_XF);
  p.SELI = (int*)(w + OFF_SELI); p.SELG = (float*)(w + OFF_SELG); p.QKR = (u16*)(w + OFF_QKR);
  return p;
}

__global__ void __launch_bounds__(NT) fwd_megakernel(KArgs ka) {
  __shared__ __attribute__((aligned(16))) char smem[SMEM_BYTES];
  __shared__ uint4 xb_words;
  if (threadIdx.x == 0) xb_words = make_uint4(0u, 0u, 0u, 0u);
  __syncthreads();
  const Params p = make_view(ka);
  XcdBarrier xb = xcd_barrier_post(p.bar, (volatile LAS unsigned*)&xb_words);
  const int bid = blockIdx.x, nb = gridDim.x;
  unsigned epoch = 0;

#if PH(0)
  RPT(0) prep_phase(p, smem);
#endif
  if (ka.flags & 1) cg::this_grid().sync();
  grid_barrier(p, epoch);

#if PH(1)
  {
    gemm_run<256>(p.Xb, p.WinT, bid, 1632, nb, [&](int t, int& m0, int& n0) { int mt = t / 12; m0 = mt * 128; n0 = (t - mt * 12) * 256; }, smem,
      [&](int m, int n, f32x4 v) {
        if (n < 1024) { v[0] = gelu_tanh(v[0]); v[1] = gelu_tanh(v[1]); v[2] = gelu_tanh(v[2]); v[3] = gelu_tanh(v[3]); }
        else if (n >= 2560) { v[0] = silu_f(v[0]); v[1] = silu_f(v[1]); v[2] = silu_f(v[2]); v[3] = silu_f(v[3]); }
        uint2 o; o.x = pk2(v[0], v[1]); o.y = pk2(v[2], v[3]);
        *(uint2*)(p.Hb + (size_t)m * 3072 + n) = o;
      });
    gemm_run<256>(p.Memb, p.WkvT, first_ge(bid, nb, 1632), 1760, nb, [&](int t, int& m0, int& n0) { int u = t - 1632; m0 = (u >> 3) * 128; n0 = (u & 7) * 256; }, smem,
      [&](int m, int n, f32x4 v) {
        float* dst = (n < 1024) ? (p.new_mem_k + (size_t)m * 1024 + n) : (p.new_mem_v + (size_t)m * 1024 + (n - 1024));
        *(f32x4*)dst = v;
        uint2 o; o.x = pk2(v[0], v[1]); o.y = pk2(v[2], v[3]);
        *(uint2*)(p.MemKVb + (size_t)m * 2048 + n) = o;
      });
  }
#endif
  grid_barrier(p, epoch);

#if PH(2)
  RPT(2) for (int t = bid; t < 1664; t += nb) {
    if (t < 512) r1_item(p, t, smem);
    else if (t < 1024) gate_prompt_item(p, t - 512, smem);
    else if (t < 1536) ret_sample_item(p, t - 1024, smem);
    else gate_sample_item(p, t - 1536, smem);
  }
#endif
  grid_barrier(p, epoch);

  for (int t = bid; t < 256; t += nb) ret_scan_item(p, t);
  grid_barrier(p, epoch);

#if PH(3)
  RPT(3) for (int t = bid; t < 512; t += nb) r3_item(p, t, smem);
#endif
  grid_barrier(p, epoch);

#if PH(4)
  {
    auto epi4 = [&](int m, int n, f32x4 v) {
      float4 xr = *(const float4*)(xin_row(p, m) + n);
      uint2 o; o.x = pk2(ALPHA_F * xr.x + v[0], ALPHA_F * xr.y + v[1]); o.y = pk2(ALPHA_F * xr.z + v[2], ALPHA_F * xr.w + v[3]);
      *(uint2*)(p.PREb + (size_t)m * 1024 + n) = o;
    };
    gemm_run<256>(p.MIXIN, p.WoT, bid, 512, nb, [&](int t, int& m0, int& n0) { m0 = (t >> 2) * 128; n0 = (t & 3) * 256; }, smem, epi4);
    gemm_run<128>(p.MIXIN, p.WoT, first_ge(bid, nb, 512), 576, nb, [&](int t, int& m0, int& n0) { int u = t - 512; m0 = (128 + (u >> 3)) * 128; n0 = (u & 7) * 128; }, smem, epi4);
    if (bid >= 64) quant_rows(p, 0, 10923, bid - 64, nb - 64);
  }
#endif
  grid_barrier(p, epoch);

  RPT(5) ln_phase(p.PREb, p.ln1_g, p.ln1_b, p.Xb);
  grid_barrier(p, epoch);

#if PH(6)
  {
    auto epi6 = [&](int m, int n, f32x4 v) {
      uint2 o; o.x = pk2(v[0] * 0.0625f, v[1] * 0.0625f); o.y = pk2(v[2] * 0.0625f, v[3] * 0.0625f);
      *(uint2*)(p.QC + (size_t)m * 1024 + n) = o;
    };
    gemm_run<256>(p.Xb, p.WqT, bid, 512, nb, [&](int t, int& m0, int& n0) { m0 = (t >> 2) * 128; n0 = (t & 3) * 256; }, smem, epi6);
    gemm_run<128>(p.Xb, p.WqT, first_ge(bid, nb, 512), 576, nb, [&](int t, int& m0, int& n0) { int u = t - 512; m0 = (128 + (u >> 3)) * 128; n0 = (u & 7) * 128; }, smem, epi6);
    if (bid >= 64) quant_rows(p, 10923, 21846, bid - 64, nb - 64);
  }
#endif
  grid_barrier(p, epoch);

#if PH(7)
  if ((nb & 1) == 0) {
    const int half = nb >> 1, hb = bid >> 1;
    if ((bid & 1) == 0) { for (int t = hb; t < 512; t += half) attn_item(p, t, smem); }
    else { for (int t = hb; t < 512; t += half) attn_item(p, 512 + t, smem); }
  } else {
    for (int t = bid; t < 1024; t += nb) attn_item(p, t, smem);
  }
#endif
  grid_barrier(p, epoch);

#if PH(8)
  {
    auto epi8 = [&](int m, int n, f32x4 v) {
      uint2 xr = *(const uint2*)(p.Xb + (size_t)m * 1024 + n);
      uint2 o; o.x = pk2(ALPHA_F * bflo(xr.x) + v[0], ALPHA_F * bfhi(xr.x) + v[1]); o.y = pk2(ALPHA_F * bflo(xr.y) + v[2], ALPHA_F * bfhi(xr.y) + v[3]);
      *(uint2*)(p.PREb + (size_t)m * 1024 + n) = o;
    };
    gemm_run<256>(p.CA, p.WcoT, bid, 512, nb, [&](int t, int& m0, int& n0) { m0 = (t >> 2) * 128; n0 = (t & 3) * 256; }, smem, epi8);
    gemm_run<128>(p.CA, p.WcoT, first_ge(bid, nb, 512), 576, nb, [&](int t, int& m0, int& n0) { int u = t - 512; m0 = (128 + (u >> 3)) * 128; n0 = (u & 7) * 128; }, smem, epi8);
    if (bid >= 64) quant_rows(p, 21846, 32768, bid - 64, nb - 64);
  }
#endif
  grid_barrier(p, epoch);

  RPT(9) ln_phase(p.PREb, p.ln2_g, p.ln2_b, p.Xb);
  grid_barrier(p, epoch);

#if PH(10)
  {
    auto epi10 = [&](int m, int n, f32x4 v) {
      uint2 o; o.x = pk2(v[0], v[1]); o.y = pk2(v[2], v[3]);
      *(uint2*)(p.PQ + (size_t)m * 2048 + n) = o;
    };
    gemm_run<256>(p.Xb, p.PwqT, bid, 1024, nb, [&](int t, int& m0, int& n0) { m0 = (t >> 3) * 128; n0 = (t & 7) * 256; }, smem, epi10);
    gemm_run<128>(p.Xb, p.PwqT, first_ge(bid, nb, 1024), 1152, nb, [&](int t, int& m0, int& n0) { int u = t - 1024; m0 = (128 + (u >> 4)) * 128; n0 = (u & 15) * 128; }, smem, epi10);
  }
#endif
  grid_barrier(p, epoch);

#if PH(11)
  __syncthreads();
  RPT(11) peer_topk_phase(p, smem);
#endif
  grid_barrier(p, epoch);

#if PH(12)
  RPT(12) peer_gather_phase(p);
#endif
}

extern "C" void kernel_launch(void* const* d_in, const int* in_sizes, int n_in, void* d_out, int out_size, void* d_ws,
                              size_t ws_size, hipStream_t stream) {
  (void)in_sizes; (void)n_in; (void)out_size;
  KArgs ka;
  memset(&ka, 0, sizeof(ka));
  for (int i = 0; i < 28; i++) ka.in[i] = (const float*)d_in[i];
  ka.out = (float*)d_out;
  ka.ws = (char*)d_ws;
  if (ws_size < WS_TOTAL) fprintf(stderr, "workspace too small: %zu < %zu\n", ws_size, (size_t)WS_TOTAL);
  static int grid_blocks = 0;
  if (!grid_blocks) {
    int dev = 0, cus = 0, per_cu = 0;
    hipGetDevice(&dev);
    hipDeviceGetAttribute(&cus, hipDeviceAttributeMultiprocessorCount, dev);
    hipOccupancyMaxActiveBlocksPerMultiprocessor(&per_cu, fwd_megakernel, NT, 0);
    if (per_cu < 1) per_cu = 1;
    if (per_cu > 1) per_cu = 1;
    grid_blocks = cus * per_cu;
  }
  hipMemsetAsync(ka.ws + OFF_BAR, 0, XCD_BAR_WORDS * 4, stream);
  void* args[] = {&ka};
  hipError_t e = hipLaunchCooperativeKernel((void*)fwd_megakernel, dim3(grid_blocks), dim3(NT), args, 0, stream);
  if (e != hipSuccess) fprintf(stderr, "cooperative launch failed: %s (grid %d)\n", hipGetErrorString(e), grid_blocks);
}
```

```cpp
#include <hip/hip_runtime.h>
#include <hip/hip_cooperative_groups.h>
#include <cstdio>
#include <cstdint>
#include <cstring>
namespace cg = cooperative_groups;

#define NT 512
#define DEVINL __device__ __forceinline__
#ifndef PHASES
#define PHASES 0xFFFF
#endif
#define PH(k) ((PHASES >> (k)) & 1)
#ifndef RPT_MASK
#define RPT_MASK 0x0
#endif
#define RPT(k) for (int rep_ = 0; rep_ < 1 + ((RPT_MASK >> (k)) & 1); rep_++)
#ifndef USE_CG_SYNC
#define USE_CG_SYNC 0
#endif

typedef unsigned short u16;
typedef short bf16x8 __attribute__((ext_vector_type(8)));
typedef short s4v __attribute__((ext_vector_type(4)));
typedef float f32x4 __attribute__((ext_vector_type(4)));

constexpr int T_ALL = 17408;
constexpr int T_P = 16384;
constexpr float ALPHA_F = 1.189207115002721f;
constexpr float LN_EPS_F = 1e-5f;
constexpr int SMEM_BYTES = 139264;

struct Params {
  const float *x_prompt, *x_sample, *mem_prompt, *cache_k, *cache_v, *state_ret, *w_in, *w_s, *b_s,
      *gate_ln_g, *gate_ln_b, *ret_gn_g, *ret_gn_b, *w_o, *ln1_g, *ln1_b, *ca_wq, *ca_wk, *ca_wv, *ca_wo,
      *ln2_g, *ln2_b, *peer_wq, *peer_subkeys, *peer_u, *peer_v, *ln3_g, *ln3_b;
  float *Y, *new_mem_k, *new_mem_v, *new_ret_prompt, *new_ret_sample, *new_gate_v;
  unsigned char *Ub8, *Vb8, *Ub4, *Vb4;
  float* Vsc4;
  float *Usc, *Vsc;
  u16 *QKR, *WinT, *WoT, *WqT, *WkvT, *WcoT, *PwqT, *SubK, *Ub, *Vb, *Xb, *Memb, *Hb, *MemKVb, *MIXIN, *QC, *CA, *PQ;
  float *rope_cos, *rope_sin, *U, *SELG;
  u16* PREb;
  u16* SP;
  int* SELI;
  unsigned* bar;
};

typedef __bf16 bf16v2 __attribute__((ext_vector_type(2)));
typedef float f32v2 __attribute__((ext_vector_type(2)));
DEVINL unsigned pk2(float a, float b) {
  f32v2 v = {a, b};
  union { bf16v2 h; unsigned u; } c;
  c.h = __builtin_convertvector(v, bf16v2);
  return c.u;
}
DEVINL u16 f2bf(float f) { return (u16)(pk2(f, 0.f) & 0xffffu); }
DEVINL float bflo(unsigned u) { return __uint_as_float(u << 16); }
DEVINL float bfhi(unsigned u) { return __uint_as_float(u & 0xffff0000u); }
DEVINL float bf1(u16 h) { return __uint_as_float(((unsigned)h) << 16); }
DEVINL void unpack8(const uint4& r, float* x) {
  x[0] = bflo(r.x); x[1] = bfhi(r.x); x[2] = bflo(r.y); x[3] = bfhi(r.y);
  x[4] = bflo(r.z); x[5] = bfhi(r.z); x[6] = bflo(r.w); x[7] = bfhi(r.w);
}
DEVINL uint4 pack8(const float* x) {
  uint4 o; o.x = pk2(x[0], x[1]); o.y = pk2(x[2], x[3]); o.z = pk2(x[4], x[5]); o.w = pk2(x[6], x[7]);
  return o;
}
DEVINL bf16x8 as_frag(const uint4& r) {
  union { uint4 u; bf16x8 f; } c; c.u = r; return c.f;
}
DEVINL f32x4 mfma16(bf16x8 a, bf16x8 b, f32x4 c) { return __builtin_amdgcn_mfma_f32_16x16x32_bf16(a, b, c, 0, 0, 0); }
DEVINL float gelu_tanh(float x) {
  float u = 0.7978845608028654f * (x + 0.044715f * x * x * x);
  float e = __expf(2.0f * u);
  float t = 1.0f - 2.0f * __builtin_amdgcn_rcpf(e + 1.0f);
  return 0.5f * x * (1.0f + t);
}
DEVINL float silu_f(float x) { return x * __builtin_amdgcn_rcpf(1.0f + __expf(-x)); }
DEVINL int sw128(int r, int c) { return r * 128 + ((c ^ (r & 7)) << 4); }
DEVINL int sw256(int r, int c) { return r * 256 + ((c ^ (r & 15)) << 4); }
DEVINL int sw512(int r, int c) { return r * 512 + ((c ^ (r & 15)) << 4); }
DEVINL bf16x8 lds_frag(const char* p) { return *(const bf16x8*)p; }
DEVINL s4v tr_read(const char* p) {
  return __builtin_amdgcn_ds_read_tr16_b64_v4i16((__attribute__((address_space(3))) s4v*)p);
}
DEVINL bf16x8 tr_frag(const char* base, int stride, int k0, int c0, int lane) {
  int grp = lane >> 4, q = (lane >> 2) & 3, pp = lane & 3;
  const char* a0 = base + (k0 + 8 * grp + q) * stride + (c0 + 4 * pp) * 2;
  s4v lo = tr_read(a0), hi = tr_read(a0 + 4 * stride);
  bf16x8 r; r[0] = lo[0]; r[1] = lo[1]; r[2] = lo[2]; r[3] = lo[3]; r[4] = hi[0]; r[5] = hi[1]; r[6] = hi[2]; r[7] = hi[3];
  return r;
}
DEVINL bf16x8 tr_frag_perm(const char* base, int stride, int k0, int c0, int lane) {
  int grp = lane >> 4, q = (lane >> 2) & 3, pp = lane & 3;
  const char* a0 = base + (k0 + 4 * grp + q) * stride + (c0 + 4 * pp) * 2;
  s4v lo = tr_read(a0), hi = tr_read(a0 + 16 * stride);
  bf16x8 r; r[0] = lo[0]; r[1] = lo[1]; r[2] = lo[2]; r[3] = lo[3]; r[4] = hi[0]; r[5] = hi[1]; r[6] = hi[2]; r[7] = hi[3];
  return r;
}
DEVINL bf16x8 pack_frag(const f32x4& a, const f32x4& b) {
  uint4 o; o.x = pk2(a[0], a[1]); o.y = pk2(a[2], a[3]); o.z = pk2(b[0], b[1]); o.w = pk2(b[2], b[3]);
  return as_frag(o);
}
DEVINL float wave_sum(float v) {
#pragma unroll
  for (int o = 32; o >= 1; o >>= 1) v += __shfl_xor(v, o);
  return v;
}
DEVINL const float* xin_row(const Params& p, int m) {
  return (m < T_P) ? (p.x_prompt + (size_t)m * 1024) : (p.x_sample + (size_t)(m - T_P) * 1024);
}

DEVINL int get_tid() { int t = threadIdx.x; asm volatile("" : "+v"(t)); return t; }

#define XB_TMO      128
#define XB_XCNT(j)  (256  + 64 * (j))
#define XB_XSUB(j)  (1280 + 64 * (j))
#define XB_XGEN(j)  (2304 + 64 * (j))
#define XB_TOP      3328
#define XB_TOPGEN   3392
#define XCD_BAR_WORDS 3456
#define XB_SPIN_CAP (1u << 22)
#define LAS __attribute__((address_space(3)))
DEVINL unsigned xb_ld(unsigned* p) { return __hip_atomic_load(p, __ATOMIC_RELAXED, __HIP_MEMORY_SCOPE_AGENT); }
DEVINL unsigned xb_add(unsigned* p, unsigned v) { return __hip_atomic_fetch_add(p, v, __ATOMIC_RELAXED, __HIP_MEMORY_SCOPE_AGENT); }
DEVINL unsigned xb_xcc_id() { return (unsigned)__builtin_amdgcn_s_getreg((3 << 11) | 20) & 0xFu; }
#define XB_SPIN(cond, bar) do { unsigned _sp = 0; while (cond) { __builtin_amdgcn_s_sleep(1); \
    if ((++_sp & 255u) == 0u) { if (xb_ld(&(bar)[XB_TMO])) break; if (_sp > XB_SPIN_CAP) { atomicAdd(&(bar)[XB_TMO], 1u); break; } } } } while (0)
struct XcdBarrier { unsigned* bar; unsigned x; volatile LAS unsigned* st; };
DEVINL XcdBarrier xcd_barrier_post(unsigned* bar, volatile LAS unsigned* st) {
  XcdBarrier b; b.bar = bar; b.x = xb_xcc_id(); b.st = st;
  if (threadIdx.x == 0) (void)xb_add(&bar[XB_XCNT(b.x)], 1u);
  return b;
}
DEVINL void xcd_barrier_complete(unsigned* bar, unsigned x, unsigned& nloc, unsigned& nx) {
  const unsigned G = gridDim.x * gridDim.y * gridDim.z;
  unsigned sum, cnt, mine, sp = 0u;
  for (;;) {
    sum = 0u; cnt = 0u; mine = 0u;
#pragma unroll
    for (unsigned j = 0; j < 16; ++j) { const unsigned c = xb_ld(&bar[XB_XCNT(j)]); sum += c; cnt += (c > 0u) ? 1u : 0u; mine = (j == x) ? c : mine; }
    if (sum == G) break;
    __builtin_amdgcn_s_sleep(1);
    if ((++sp & 255u) == 0u) { if (xb_ld(&bar[XB_TMO])) break; if (sp > XB_SPIN_CAP) { atomicAdd(&bar[XB_TMO], 1u); break; } }
  }
  nloc = mine > 0u ? mine : 1u; nx = cnt > 0u ? cnt : 1u;
}
DEVINL void xcd_barrier(const XcdBarrier& b) {
  asm volatile("s_waitcnt vmcnt(0)" ::: "memory");
  __syncthreads();
  if (threadIdx.x == 0) {
    unsigned* bar = b.bar;
    __builtin_amdgcn_s_waitcnt(0);
    unsigned nloc = b.st[0], nx = b.st[1];
    if (nloc == 0u) { xcd_barrier_complete(bar, b.x, nloc, nx); b.st[0] = nloc; b.st[1] = nx; }
    const unsigned old = xb_add(&bar[XB_XSUB(b.x)], 1u);
    const unsigned gen = old / nloc;
    if (old + 1u == (gen + 1u) * nloc) {
      __builtin_amdgcn_fence(__ATOMIC_RELEASE, "agent");
      asm volatile("s_waitcnt vmcnt(0)" ::: "memory");
      const unsigned og = xb_add(&bar[XB_TOP], 1u);
      const unsigned tg = og / nx;
      if (og + 1u == (tg + 1u) * nx) xb_add(&bar[XB_TOPGEN], 1u);
      else XB_SPIN(xb_ld(&bar[XB_TOPGEN]) == tg, bar);
      __builtin_amdgcn_fence(__ATOMIC_ACQUIRE, "agent");
      xb_add(&bar[XB_XGEN(b.x)], 1u);
      asm volatile("s_waitcnt vmcnt(0)" ::: "memory");
    } else {
      XB_SPIN(xb_ld(&bar[XB_XGEN(b.x)]) == gen, bar);
      __builtin_amdgcn_fence(__ATOMIC_ACQUIRE, "agent");
      asm volatile("s_waitcnt vmcnt(0)" ::: "memory");
    }
  }
  __syncthreads();
}
#define grid_barrier(p, epoch) xcd_barrier(xb)

DEVINL void cvt_range(const float* __restrict__ src, u16* __restrict__ dst, size_t n8) {
  size_t stride = (size_t)gridDim.x * NT;
  const int tid_ = get_tid();
  for (size_t i = (size_t)blockIdx.x * NT + tid_; i < n8; i += stride) {
    float4 a = ((const float4*)src)[2 * i], b = ((const float4*)src)[2 * i + 1];
    uint4 o; o.x = pk2(a.x, a.y); o.y = pk2(a.z, a.w); o.z = pk2(b.x, b.y); o.w = pk2(b.z, b.w);
    ((uint4*)dst)[i] = o;
  }
}
DEVINL void transpose_tile(const float* __restrict__ W, int N, u16* __restrict__ WT, int tile, float* tl) {
  const int tid = get_tid();
  int ntn = N >> 6;
  int kt = tile / ntn, nt = tile - kt * ntn;
  int k0 = kt * 64, n0 = nt * 64;
#pragma unroll
  for (int i = 0; i < 2; i++) {
    int r = (tid >> 4) + 32 * i, c4 = (tid & 15) * 4;
    float4 v = *(const float4*)(W + (size_t)(k0 + r) * N + n0 + c4);
    tl[(c4 + 0) * 65 + r] = v.x; tl[(c4 + 1) * 65 + r] = v.y; tl[(c4 + 2) * 65 + r] = v.z; tl[(c4 + 3) * 65 + r] = v.w;
  }
  __syncthreads();
  {
    int n = tid >> 3, k8 = (tid & 7) * 8;
    float x[8];
#pragma unroll
    for (int j = 0; j < 8; j++) x[j] = tl[n * 65 + k8 + j];
    *(uint4*)(WT + (size_t)(n0 + n) * 1024 + k0 + k8) = pack8(x);
  }
  __syncthreads();
}
DEVINL void quant_rows(const Params& p, int r0, int r1, int hb, int nh) {
  const int tid_ = get_tid(); const int lane = tid_ & 63, wid = __builtin_amdgcn_readfirstlane(tid_ >> 6);
  for (int rr = r0 + hb * 8 + wid; rr < r1; rr += nh * 8) {
    const bool isv = rr >= 16384;
    const int row = isv ? rr - 16384 : rr;
    const float* src = isv ? p.peer_v : p.peer_u;
    unsigned char* dst = isv ? p.Vb8 : p.Ub8;
    float* inv_scale = isv ? p.Vsc : p.Usc;
    const float* rp = src + (size_t)row * 1024 + lane * 16;
    float4 a = *(const float4*)rp, b = *(const float4*)(rp + 4), c = *(const float4*)(rp + 8), d = *(const float4*)(rp + 12);
    float m = fmaxf(fmaxf(fmaxf(fabsf(a.x), fabsf(a.y)), fmaxf(fabsf(a.z), fabsf(a.w))), fmaxf(fmaxf(fabsf(b.x), fabsf(b.y)), fmaxf(fabsf(b.z), fabsf(b.w))));
    m = fmaxf(m, fmaxf(fmaxf(fmaxf(fabsf(c.x), fabsf(c.y)), fmaxf(fabsf(c.z), fabsf(c.w))), fmaxf(fmaxf(fabsf(d.x), fabsf(d.y)), fmaxf(fabsf(d.z), fabsf(d.w)))));
#pragma unroll
    for (int o = 32; o >= 1; o >>= 1) m = fmaxf(m, __shfl_xor(m, o));
    if (isv) {
      const float sc = m > 0.f ? 224.0f / m : 1.0f;
      uint4 q;
      int w0 = 0, w1 = 0, w2 = 0, w3 = 0;
      w0 = __builtin_amdgcn_cvt_pk_fp8_f32(a.x * sc, a.y * sc, w0, false); w0 = __builtin_amdgcn_cvt_pk_fp8_f32(a.z * sc, a.w * sc, w0, true);
      w1 = __builtin_amdgcn_cvt_pk_fp8_f32(b.x * sc, b.y * sc, w1, false); w1 = __builtin_amdgcn_cvt_pk_fp8_f32(b.z * sc, b.w * sc, w1, true);
      w2 = __builtin_amdgcn_cvt_pk_fp8_f32(c.x * sc, c.y * sc, w2, false); w2 = __builtin_amdgcn_cvt_pk_fp8_f32(c.z * sc, c.w * sc, w2, true);
      w3 = __builtin_amdgcn_cvt_pk_fp8_f32(d.x * sc, d.y * sc, w3, false); w3 = __builtin_amdgcn_cvt_pk_fp8_f32(d.z * sc, d.w * sc, w3, true);
      q.x = (unsigned)w0; q.y = (unsigned)w1; q.z = (unsigned)w2; q.w = (unsigned)w3;
      *(uint4*)(dst + (size_t)row * 1024 + lane * 16) = q;
      if (lane == 0) inv_scale[row] = m > 0.f ? m / 224.0f : 1.0f;
    }
    {
      const float xv[16] = {a.x, a.y, a.z, a.w, b.x, b.y, b.z, b.w, c.x, c.y, c.z, c.w, d.x, d.y, d.z, d.w};
      float ss = 0.f;
#pragma unroll
      for (int i = 0; i < 16; i++) ss += xv[i] * xv[i];
      ss = wave_sum(ss);
      float clipv = 2.6f * sqrtf(ss * (1.0f / 1024.0f));
      clipv = fminf(clipv, m);
      const float sc = clipv > 0.f ? 7.0f / clipv : 1.0f;
      unsigned w0 = 0u, w1 = 0u;
#pragma unroll
      for (int i = 0; i < 8; i++) {
        int q0 = (int)rintf(xv[i] * sc), q1 = (int)rintf(xv[i + 8] * sc);
        q0 = q0 < -7 ? -7 : (q0 > 7 ? 7 : q0); q1 = q1 < -7 ? -7 : (q1 > 7 ? 7 : q1);
        w0 |= (isv ? (unsigned)(q0 + 8) : ((unsigned)q0 & 15u)) << (4 * i);
        w1 |= (isv ? (unsigned)(q1 + 8) : ((unsigned)q1 & 15u)) << (4 * i);
      }
      *(uint2*)((isv ? p.Vb4 : p.Ub4) + (size_t)row * 512 + lane * 8) = make_uint2(w0, w1);
      if (lane == 0) (isv ? p.Vsc4 : p.Usc)[row] = clipv > 0.f ? clipv / 7.0f : 1.0f;
    }
  }
}
DEVINL void prep_phase(const Params& p, char* smem) {
  float* tl = (float*)smem;
  for (int t = blockIdx.x; t < 2560; t += gridDim.x) {
    if (t < 768) transpose_tile(p.w_in, 3072, p.WinT, t, tl);
    else if (t < 1024) transpose_tile(p.w_o, 1024, p.WoT, t - 768, tl);
    else if (t < 1280) transpose_tile(p.ca_wq, 1024, p.WqT, t - 1024, tl);
    else if (t < 1536) transpose_tile(p.ca_wk, 1024, p.WkvT, t - 1280, tl);
    else if (t < 1792) transpose_tile(p.ca_wv, 1024, p.WkvT + (size_t)1024 * 1024, t - 1536, tl);
    else if (t < 2048) transpose_tile(p.ca_wo, 1024, p.WcoT, t - 1792, tl);
    else transpose_tile(p.peer_wq, 2048, p.PwqT, t - 2048, tl);
  }
  cvt_range(p.x_prompt, p.Xb, (size_t)T_P * 1024 / 8);
  cvt_range(p.x_sample, p.Xb + (size_t)T_P * 1024, (size_t)1024 * 1024 / 8);
  cvt_range(p.mem_prompt, p.Memb, (size_t)2048 * 1024 / 8);
  cvt_range(p.peer_subkeys, p.SubK, (size_t)262144 / 8);
  for (int i = blockIdx.x * NT + get_tid(); i < 2056 * 64; i += gridDim.x * NT) {
    int pr = i >> 6, j = i & 63;
    int pos = pr < 2048 ? pr : 16384 + (pr - 2048);
    float inv = (float)exp(-((double)j / 64.0) * 9.210340371976184);
    float ang = (float)pos * inv;
    double a = (double)ang;
    double k = rint(a * 0.15915494309189535);
    double r = fma(-k, 6.283185307179586, a);
    r = fma(-k, 2.4492935982947064e-16, r);
    float rf = (float)r;
    float s, c;
    sincosf(rf, &s, &c);
    p.rope_cos[i] = c;
    p.rope_sin[i] = s;
  }
}

typedef unsigned int u32x4 __attribute__((ext_vector_type(4)));
struct Stg { u32x4 a0, a1, b0, b1, b2, b3; };
template <int BCH>
DEVINL void g_load(Stg& s, const u16* Ap, const u16* Bp, int kt) {
  s.a0 = *(const u32x4*)(Ap + kt * 64);
  s.a1 = *(const u32x4*)(Ap + (size_t)64 * 1024 + kt * 64);
  s.b0 = *(const u32x4*)(Bp + kt * 64);
  s.b1 = *(const u32x4*)(Bp + (size_t)64 * 1024 + kt * 64);
  if (BCH == 4) {
    s.b2 = *(const u32x4*)(Bp + (size_t)128 * 1024 + kt * 64);
    s.b3 = *(const u32x4*)(Bp + (size_t)192 * 1024 + kt * 64);
  }
}
template <int BCH>
DEVINL void s_store(const Stg& s, char* da, int lr, int lc) {
  *(u32x4*)(da + sw128(lr, lc)) = s.a0;
  *(u32x4*)(da + sw128(lr + 64, lc)) = s.a1;
  char* db = da + 128 * 128;
  *(u32x4*)(db + sw128(lr, lc)) = s.b0;
  *(u32x4*)(db + sw128(lr + 64, lc)) = s.b1;
  if (BCH == 4) {
    *(u32x4*)(db + sw128(lr + 128, lc)) = s.b2;
    *(u32x4*)(db + sw128(lr + 192, lc)) = s.b3;
  }
}
template <int BN, int NTW>
DEVINL void g_compute(f32x4 (&acc)[4][NTW], const char* sa, int wm, int wn, int l15, int g4) {
  const char* sb = sa + 128 * 128;
#pragma unroll
  for (int ks = 0; ks < 2; ks++) {
    bf16x8 af[4], bfr[NTW];
    const int c = ks * 4 + g4;
#pragma unroll
    for (int mi = 0; mi < 4; mi++) af[mi] = lds_frag(sa + sw128(wm * 64 + mi * 16 + l15, c));
#pragma unroll
    for (int ni = 0; ni < NTW; ni++) bfr[ni] = lds_frag(sb + sw128(wn * (BN / 4) + ni * 16 + l15, c));
#pragma unroll
    for (int mi = 0; mi < 4; mi++)
#pragma unroll
      for (int ni = 0; ni < NTW; ni++) acc[mi][ni] = mfma16(bfr[ni], af[mi], acc[mi][ni]);
  }
}
template <int BN, class Epi>
DEVINL void gemm_tile(const u16* __restrict__ A, const u16* __restrict__ Bt, int m0, int n0, char* smem, Epi epi) {
  constexpr int K = 1024, NKT = 16;
  constexpr int NTW = BN / 64;
  constexpr int STAGE = 128 * 128 + BN * 128;
  constexpr int BCH = BN * 8 / NT;
  const int tid = get_tid(), lane = tid & 63, wid = tid >> 6, wm = wid >> 2, wn = wid & 3;
  const int l15 = lane & 15, g4 = lane >> 4;
  f32x4 acc[4][NTW];
#pragma unroll
  for (int i = 0; i < 4; i++)
#pragma unroll
    for (int j = 0; j < NTW; j++) acc[i][j] = (f32x4){0.f, 0.f, 0.f, 0.f};
  Stg s0, s1;
  const int lr = tid >> 3, lc = tid & 7;
  const u16* Ap = A + (size_t)(m0 + lr) * K + lc * 8;
  const u16* Bp = Bt + (size_t)(n0 + lr) * K + lc * 8;
  g_load<BCH>(s0, Ap, Bp, 0);
  s_store<BCH>(s0, smem, lr, lc);
  g_load<BCH>(s1, Ap, Bp, 1);
  g_load<BCH>(s0, Ap, Bp, 2);
  __syncthreads();
#pragma unroll 4
  for (int kt = 0; kt < NKT; kt += 2) {
    s_store<BCH>(s1, smem + STAGE, lr, lc);
    if (kt + 3 < NKT) g_load<BCH>(s1, Ap, Bp, kt + 3);
    g_compute<BN, NTW>(acc, smem, wm, wn, l15, g4);
    __syncthreads();
    if (kt + 2 < NKT) s_store<BCH>(s0, smem, lr, lc);
    if (kt + 4 < NKT) g_load<BCH>(s0, Ap, Bp, kt + 4);
    g_compute<BN, NTW>(acc, smem + STAGE, wm, wn, l15, g4);
    __syncthreads();
  }
#pragma unroll
  for (int mi = 0; mi < 4; mi++)
#pragma unroll
    for (int ni = 0; ni < NTW; ni++) {
      int m = m0 + wm * 64 + mi * 16 + l15;
      int n = n0 + wn * (BN / 4) + ni * 16 + g4 * 4;
      epi(m, n, acc[mi][ni]);
    }
}

template <int BN, class Coord, class Epi>
DEVINL void gemm_run(const u16* __restrict__ A, const u16* __restrict__ Bt, int t0, int t1, int tstep, Coord coord, char* smem, Epi epi) {
  if (t0 >= t1) return;
  constexpr int K = 1024, NKT = 16;
  constexpr int NTW = BN / 64;
  constexpr int STAGE = 128 * 128 + BN * 128;
  constexpr int BCH = BN * 8 / NT;
  const int tid = get_tid(), lane = tid & 63, wid = tid >> 6, wm = wid >> 2, wn = wid & 3;
  const int l15 = lane & 15, g4 = lane >> 4;
  const int lr = tid >> 3, lc = tid & 7;
  int m0, n0;
  coord(t0, m0, n0);
  const u16* Ap = A + (size_t)(m0 + lr) * K + lc * 8;
  const u16* Bp = Bt + (size_t)(n0 + lr) * K + lc * 8;
  Stg s0, s1;
  g_load<BCH>(s0, Ap, Bp, 0);
  g_load<BCH>(s1, Ap, Bp, 1);
  for (int t = t0; t < t1; t += tstep) {
    f32x4 acc[4][NTW];
#pragma unroll
    for (int i = 0; i < 4; i++)
#pragma unroll
      for (int j = 0; j < NTW; j++) acc[i][j] = (f32x4){0.f, 0.f, 0.f, 0.f};
    s_store<BCH>(s0, smem, lr, lc);
    g_load<BCH>(s0, Ap, Bp, 2);
    __syncthreads();
#pragma unroll 4
    for (int kt = 0; kt < NKT; kt += 2) {
      s_store<BCH>(s1, smem + STAGE, lr, lc);
      if (kt + 3 < NKT) g_load<BCH>(s1, Ap, Bp, kt + 3);
      g_compute<BN, NTW>(acc, smem, wm, wn, l15, g4);
      __syncthreads();
      if (kt + 2 < NKT) s_store<BCH>(s0, smem, lr, lc);
      if (kt + 4 < NKT) g_load<BCH>(s0, Ap, Bp, kt + 4);
      g_compute<BN, NTW>(acc, smem + STAGE, wm, wn, l15, g4);
      __syncthreads();
    }
    const int tn = t + tstep;
    int m0n = m0, n0n = n0;
    if (tn < t1) {
      coord(tn, m0n, n0n);
      Ap = A + (size_t)(m0n + lr) * K + lc * 8;
      Bp = Bt + (size_t)(n0n + lr) * K + lc * 8;
      g_load<BCH>(s0, Ap, Bp, 0);
      g_load<BCH>(s1, Ap, Bp, 1);
    }
#pragma unroll
    for (int mi = 0; mi < 4; mi++)
#pragma unroll
      for (int ni = 0; ni < NTW; ni++) {
        int m = m0 + wm * 64 + mi * 16 + l15;
        int n = n0 + wn * (BN / 4) + ni * 16 + g4 * 4;
        epi(m, n, acc[mi][ni]);
      }
    m0 = m0n; n0 = n0n;
  }
}
DEVINL int first_ge(int bid, int nb, int lo) { return bid >= lo ? bid : bid + ((lo - bid + nb - 1) / nb) * nb; }

DEVINL void ln_phase(const u16* __restrict__ pre, const float* __restrict__ gam, const float* __restrict__ bet,
                     u16* __restrict__ outb) {
  const int tid_ = get_tid(); const int lane = tid_ & 63, wid = __builtin_amdgcn_readfirstlane(tid_ >> 6);
  for (int row = blockIdx.x * 8 + wid; row < T_ALL; row += gridDim.x * 8) {
    float v[16];
    {
      uint4 a = *(const uint4*)(pre + (size_t)row * 1024 + lane * 8);
      uint4 b = *(const uint4*)(pre + (size_t)row * 1024 + 512 + lane * 8);
      unpack8(a, v); unpack8(b, v + 8);
    }
    float s = 0.f;
#pragma unroll
    for (int i = 0; i < 16; i++) s += v[i];
    float mean = wave_sum(s) * (1.0f / 1024.0f);
    float q = 0.f;
#pragma unroll
    for (int i = 0; i < 16; i++) { float d = v[i] - mean; q += d * d; }
    float rstd = rsqrtf(wave_sum(q) * (1.0f / 1024.0f) + LN_EPS_F);
#pragma unroll
    for (int hf = 0; hf < 2; hf++) {
      int col = hf * 512 + lane * 8;
      float4 g0 = *(const float4*)(gam + col), g1 = *(const float4*)(gam + col + 4);
      float4 b0 = *(const float4*)(bet + col), b1 = *(const float4*)(bet + col + 4);
      float y[8];
      const float* o = v + hf * 8;
      y[0] = (o[0] - mean) * rstd * g0.x + b0.x; y[1] = (o[1] - mean) * rstd * g0.y + b0.y;
      y[2] = (o[2] - mean) * rstd * g0.z + b0.z; y[3] = (o[3] - mean) * rstd * g0.w + b0.w;
      y[4] = (o[4] - mean) * rstd * g1.x + b1.x; y[5] = (o[5] - mean) * rstd * g1.y + b1.y;
      y[6] = (o[6] - mean) * rstd * g1.z + b1.z; y[7] = (o[7] - mean) * rstd * g1.w + b1.w;
      *(uint4*)(outb + (size_t)row * 1024 + col) = pack8(y);
    }
  }
}

DEVINL void gate_prompt_item(const Params& p, int id, char* smem) {
  const int tid = get_tid(), lane = tid & 63, wid = tid >> 6, l15 = lane & 15, g4 = lane >> 4;
  const int b = id >> 6, n = (id >> 2) & 15, g = id & 3;
  const int tok0 = b * 2048 + n * 128;
  char* WsL = smem;
  char* VnL = smem + 32768;
  const float* ws = p.w_s + g * 16384;
#pragma unroll
  for (int i = 0; i < 4; i++) {
    int q = tid + i * 512, t = q >> 4, c = q & 15, s0 = c * 8;
    float4 a = *(const float4*)(ws + t * 128 + s0), bb = *(const float4*)(ws + t * 128 + s0 + 4);
    float x[8] = {a.x, a.y, a.z, a.w, bb.x, bb.y, bb.z, bb.w};
#pragma unroll
    for (int j = 0; j < 8; j++) x[j] = (s0 + j <= t) ? x[j] : 0.f;
    *(uint4*)(WsL + sw256(t, c)) = pack8(x);
  }
#pragma unroll
  for (int i = 0; i < 4; i++) {
    int q = tid + i * 512, s = q >> 4, c = q & 15;
    uint4 raw = *(const uint4*)(p.Hb + (size_t)(tok0 + s) * 3072 + 512 + g * 128 + c * 8);
    float x[8]; unpack8(raw, x);
    float sum = 0.f;
#pragma unroll
    for (int j = 0; j < 8; j++) sum += x[j];
    sum += __shfl_xor(sum, 1); sum += __shfl_xor(sum, 2); sum += __shfl_xor(sum, 4); sum += __shfl_xor(sum, 8);
    float mean = sum * (1.0f / 128.0f);
    float var = 0.f;
#pragma unroll
    for (int j = 0; j < 8; j++) { float d = x[j] - mean; var += d * d; }
    var += __shfl_xor(var, 1); var += __shfl_xor(var, 2); var += __shfl_xor(var, 4); var += __shfl_xor(var, 8);
    float rstd = rsqrtf(var * (1.0f / 128.0f) + LN_EPS_F);
    const float* gp = p.gate_ln_g + g * 128 + c * 8;
    const float* bp = p.gate_ln_b + g * 128 + c * 8;
#pragma unroll
    for (int j = 0; j < 8; j++) x[j] = (x[j] - mean) * rstd * gp[j] + bp[j];
    *(uint4*)(VnL + s * 272 + c * 16) = pack8(x);
  }
  __syncthreads();
  f32x4 acc[8];
#pragma unroll
  for (int i = 0; i < 8; i++) acc[i] = (f32x4){0.f, 0.f, 0.f, 0.f};
#pragma unroll
  for (int ks = 0; ks < 4; ks++) {
    bf16x8 af = tr_frag(VnL, 272, 32 * ks, 16 * wid, lane);
#pragma unroll
    for (int ti = 0; ti < 8; ti++) {
      if (32 * ks <= 16 * ti + 15) {
        bf16x8 bw = lds_frag(WsL + sw256(16 * ti + l15, ks * 4 + g4));
        acc[ti] = mfma16(af, bw, acc[ti]);
      }
    }
  }
#pragma unroll
  for (int ti = 0; ti < 8; ti++) {
    int t = 16 * ti + l15, c = 16 * wid + 4 * g4, tok = tok0 + t;
    float bs = p.b_s[g * 128 + t];
    uint2 ua = *(const uint2*)(p.Hb + (size_t)tok * 3072 + g * 128 + c);
    float o0 = bflo(ua.x) * (acc[ti][0] + bs), o1 = bfhi(ua.x) * (acc[ti][1] + bs);
    float o2 = bflo(ua.y) * (acc[ti][2] + bs), o3 = bfhi(ua.y) * (acc[ti][3] + bs);
    uint2 o; o.x = pk2(o0, o1); o.y = pk2(o2, o3);
    *(uint2*)(p.MIXIN + (size_t)tok * 1024 + g * 128 + c) = o;
  }
  __syncthreads();
}

DEVINL void r1_item(const Params& p, int id, char* smem) {
  const int tid = get_tid(), lane = tid & 63, wid = tid >> 6, l15 = lane & 15, g4 = lane >> 4;
  const int b = id >> 6, h = (id >> 4) & 3, n = id & 15;
  const int tok0 = b * 2048 + n * 128;
  char* KL = smem;
  char* VL = smem + 34816;
  const float lg = logf(1.0f - exp2f(-5.0f - (float)h));
#pragma unroll
  for (int i = 0; i < 2; i++) {
    int q = tid + i * 512, j = q >> 3, ch = q & 7;
    int pr = n * 128 + j;
    float cs[8], sn[8];
    {
      float4 c0 = *(const float4*)(p.rope_cos + pr * 64 + ch * 8), c1 = *(const float4*)(p.rope_cos + pr * 64 + ch * 8 + 4);
      float4 s0 = *(const float4*)(p.rope_sin + pr * 64 + ch * 8), s1 = *(const float4*)(p.rope_sin + pr * 64 + ch * 8 + 4);
      cs[0] = c0.x; cs[1] = c0.y; cs[2] = c0.z; cs[3] = c0.w; cs[4] = c1.x; cs[5] = c1.y; cs[6] = c1.z; cs[7] = c1.w;
      sn[0] = s0.x; sn[1] = s0.y; sn[2] = s0.z; sn[3] = s0.w; sn[4] = s1.x; sn[5] = s1.y; sn[6] = s1.z; sn[7] = s1.w;
    }
    u16* rowp = p.Hb + (size_t)(tok0 + j) * 3072;
    {
      u16* qp = rowp + 1024 + h * 128 + ch * 8;
      uint4 a = *(const uint4*)qp, bb = *(const uint4*)(qp + 64);
      float x1[8], x2[8], o1[8], o2[8];
      unpack8(a, x1); unpack8(bb, x2);
#pragma unroll
      for (int e = 0; e < 8; e++) { o1[e] = x1[e] * cs[e] - x2[e] * sn[e]; o2[e] = x1[e] * sn[e] + x2[e] * cs[e]; }
      u16* qo = p.QKR + (size_t)(tok0 + j) * 1024 + h * 128 + ch * 8;
      *(uint4*)qo = pack8(o1);
      *(uint4*)(qo + 64) = pack8(o2);
    }
    {
      u16* kp = rowp + 1536 + h * 128 + ch * 8;
      uint4 a = *(const uint4*)kp, bb = *(const uint4*)(kp + 64);
      float x1[8], x2[8], o1[8], o2[8];
      unpack8(a, x1); unpack8(bb, x2);
      const float sc = 0.08838834764831845f;
#pragma unroll
      for (int e = 0; e < 8; e++) { o1[e] = (x1[e] * cs[e] - x2[e] * sn[e]) * sc; o2[e] = (x1[e] * sn[e] + x2[e] * cs[e]) * sc; }
      u16* ko = p.QKR + (size_t)(tok0 + j) * 1024 + 512 + h * 128 + ch * 8;
      *(uint4*)ko = pack8(o1);
      *(uint4*)(ko + 64) = pack8(o2);
      float dec = __expf(lg * (float)(127 - j));
#pragma unroll
      for (int e = 0; e < 8; e++) { o1[e] *= dec; o2[e] *= dec; }
      *(uint4*)(KL + j * 272 + ch * 16) = pack8(o1);
      *(uint4*)(KL + j * 272 + (ch + 8) * 16) = pack8(o2);
    }
  }
#pragma unroll
  for (int i = 0; i < 4; i++) {
    int q = tid + i * 512, j = q >> 4, c = q & 15;
    *(uint4*)(VL + j * 272 + c * 16) = *(const uint4*)(p.Hb + (size_t)(tok0 + j) * 3072 + 2048 + h * 128 + c * 8);
  }
  __syncthreads();
  f32x4 acc[8];
#pragma unroll
  for (int i = 0; i < 8; i++) acc[i] = (f32x4){0.f, 0.f, 0.f, 0.f};
#pragma unroll
  for (int ks = 0; ks < 4; ks++) {
    bf16x8 af = tr_frag(VL, 272, 32 * ks, 16 * wid, lane);
#pragma unroll
    for (int dt = 0; dt < 8; dt++) {
      bf16x8 bk = tr_frag(KL, 272, 32 * ks, 16 * dt, lane);
      acc[dt] = mfma16(af, bk, acc[dt]);
    }
  }
  float* U = p.U + (size_t)id * 16384;
#pragma unroll
  for (int dt = 0; dt < 8; dt++)
#pragma unroll
    for (int r = 0; r < 4; r++) U[(16 * wid + 4 * g4 + r) * 128 + 16 * dt + l15] = acc[dt][r];
  __syncthreads();
}

DEVINL void ret_sample_item(const Params& p, int id, char* smem) {
  const int tid = get_tid(), lane = tid & 63, wid = tid >> 6;
  const int b = id >> 2, h = id & 3;
  float* qf = (float*)smem;
  float* kf = qf + 1024;
  float* kd = kf + 1024;
  float* vf = kd + 1024;
  float* PL = vf + 1024;
  float* red = PL + 64;
  const float lg = logf(1.0f - exp2f(-5.0f - (float)h));
  {
    int i = tid >> 6, dp = tid & 63;
    int tok = T_P + b * 8 + i, pr = 2048 + i;
    float c = p.rope_cos[pr * 64 + dp], s = p.rope_sin[pr * 64 + dp];
    const u16* rowp = p.Hb + (size_t)tok * 3072;
    float q1 = bf1(rowp[1024 + h * 128 + dp]), q2 = bf1(rowp[1024 + h * 128 + 64 + dp]);
    qf[i * 128 + dp] = q1 * c - q2 * s;
    qf[i * 128 + 64 + dp] = q1 * s + q2 * c;
    const float sc = 0.08838834764831845f;
    float k1 = bf1(rowp[1536 + h * 128 + dp]), k2 = bf1(rowp[1536 + h * 128 + 64 + dp]);
    float ka = (k1 * c - k2 * s) * sc, kb = (k1 * s + k2 * c) * sc;
    kf[i * 128 + dp] = ka; kf[i * 128 + 64 + dp] = kb;
    float dec = __expf(lg * (float)(7 - i));
    kd[i * 128 + dp] = ka * dec; kd[i * 128 + 64 + dp] = kb * dec;
    vf[i * 128 + dp] = bf1(rowp[2048 + h * 128 + dp]);
    vf[i * 128 + 64 + dp] = bf1(rowp[2048 + h * 128 + 64 + dp]);
  }
  __syncthreads();
  if (tid < 64) {
    int i = tid >> 3, j = tid & 7;
    float s = 0.f;
    if (j <= i) {
      for (int d = 0; d < 128; d++) s += qf[i * 128 + d] * kf[j * 128 + d];
      s *= __expf(lg * (float)(i - j));
    }
    PL[tid] = s;
  }
  {
    int e = tid & 127, dq = tid >> 7;
    const float* S0 = p.state_ret + (size_t)(b * 4 + h) * 16384;
    float* Sn = p.new_ret_sample + (size_t)(b * 4 + h) * 16384;
    float part[8], vv[8];
#pragma unroll
    for (int i = 0; i < 8; i++) { part[i] = 0.f; vv[i] = vf[i * 128 + e]; }
    const float c8 = __expf(lg * 8.0f);
    float s0v[32];
#pragma unroll
    for (int dd = 0; dd < 32; dd++) s0v[dd] = S0[(dq * 32 + dd) * 128 + e];
#pragma unroll
    for (int dd = 0; dd < 32; dd++) {
      const int d = dq * 32 + dd;
      float s = s0v[dd];
      float sn = s * c8;
#pragma unroll
      for (int j = 0; j < 8; j++) sn += kd[j * 128 + d] * vv[j];
      Sn[d * 128 + e] = sn;
#pragma unroll
      for (int i = 0; i < 8; i++) part[i] += qf[i * 128 + d] * s;
    }
#pragma unroll
    for (int i = 0; i < 8; i++) red[(dq * 8 + i) * 128 + e] = part[i];
  }
  __syncthreads();
  {
    int i = wid;
    int tok = T_P + b * 8 + i;
    float qdec = __expf(lg * (float)(i + 1));
    float o[2];
#pragma unroll
    for (int hf = 0; hf < 2; hf++) {
      int e = lane + 64 * hf;
      float a = 0.f;
#pragma unroll
      for (int j = 0; j < 8; j++) a += PL[i * 8 + j] * vf[j * 128 + e];
      float r = red[(0 * 8 + i) * 128 + e] + red[(1 * 8 + i) * 128 + e] + red[(2 * 8 + i) * 128 + e] + red[(3 * 8 + i) * 128 + e];
      o[hf] = a + qdec * r;
    }
    float mean = wave_sum(o[0] + o[1]) * (1.0f / 128.0f);
    float d0 = o[0] - mean, d1 = o[1] - mean;
    float rstd = rsqrtf(wave_sum(d0 * d0 + d1 * d1) * (1.0f / 128.0f) + LN_EPS_F);
#pragma unroll
    for (int hf = 0; hf < 2; hf++) {
      int e = lane + 64 * hf;
      float on = (o[hf] - mean) * rstd * p.ret_gn_g[h * 128 + e] + p.ret_gn_b[h * 128 + e];
      float sg = bf1(p.Hb[(size_t)tok * 3072 + 2560 + h * 128 + e]);
      p.MIXIN[(size_t)tok * 1024 + 512 + h * 128 + e] = f2bf(sg * on);
    }
  }
  __syncthreads();
}

DEVINL void gate_sample_item(const Params& p, int b, char* smem) {
  const int tid = get_tid(), lane = tid & 63, wid = tid >> 6;
  float* VS = (float*)smem;
  {
    int s = wid, tok = T_P + b * 8 + s;
    uint4 raw = *(const uint4*)(p.Hb + (size_t)tok * 3072 + 512 + lane * 8);
    float x[8]; unpack8(raw, x);
    float sum = 0.f;
#pragma unroll
    for (int j = 0; j < 8; j++) sum += x[j];
    sum += __shfl_xor(sum, 1); sum += __shfl_xor(sum, 2); sum += __shfl_xor(sum, 4); sum += __shfl_xor(sum, 8);
    float mean = sum * (1.0f / 128.0f);
    float var = 0.f;
#pragma unroll
    for (int j = 0; j < 8; j++) { float d = x[j] - mean; var += d * d; }
    var += __shfl_xor(var, 1); var += __shfl_xor(var, 2); var += __shfl_xor(var, 4); var += __shfl_xor(var, 8);
    float rstd = rsqrtf(var * (1.0f / 128.0f) + LN_EPS_F);
#pragma unroll
    for (int j = 0; j < 8; j++) x[j] = (x[j] - mean) * rstd * p.gate_ln_g[lane * 8 + j] + p.gate_ln_b[lane * 8 + j];
    float* go = p.new_gate_v + (size_t)(b * 8 + s) * 512 + lane * 8;
    *(float4*)go = make_float4(x[0], x[1], x[2], x[3]);
    *(float4*)(go + 4) = make_float4(x[4], x[5], x[6], x[7]);
#pragma unroll
    for (int j = 0; j < 8; j++) VS[s * 512 + lane * 8 + j] = x[j];
  }
  __syncthreads();
  {
    int g = tid >> 7;
    float vs[8];
#pragma unroll
    for (int s = 0; s < 8; s++) vs[s] = VS[s * 512 + tid];
#pragma unroll
    for (int t = 0; t < 8; t++) {
      float mixed = p.b_s[g * 128 + t];
#pragma unroll
      for (int s = 0; s < 8; s++)
        if (s <= t) mixed += p.w_s[g * 16384 + t * 128 + s] * vs[s];
      int tok = T_P + b * 8 + t;
      float ua = bf1(p.Hb[(size_t)tok * 3072 + tid]);
      p.MIXIN[(size_t)tok * 1024 + tid] = f2bf(ua * mixed);
    }
  }
  __syncthreads();
}

DEVINL void ret_scan_item(const Params& p, int id) {
  const int tid = get_tid();
  const int bh = id >> 3, q = (id & 7) * 512 + tid, h = bh & 3;
  const float lg = logf(1.0f - exp2f(-5.0f - (float)h));
  const float c128 = __expf(lg * 128.0f);
  const float4* ub = (const float4*)(p.U + (size_t)(bh * 16) * 16384) + q;
  float4 u[16];
#pragma unroll
  for (int n = 0; n < 16; n++) u[n] = ub[(size_t)n * 4096];
  float4 sv = make_float4(0.f, 0.f, 0.f, 0.f);
  uint2* sp = (uint2*)(p.SP + (size_t)(bh * 16) * 16384) + q;
#pragma unroll
  for (int n = 0; n < 16; n++) {
    uint2 o; o.x = pk2(sv.x, sv.y); o.y = pk2(sv.z, sv.w);
    sp[(size_t)n * 4096] = o;
    sv.x = sv.x * c128 + u[n].x; sv.y = sv.y * c128 + u[n].y; sv.z = sv.z * c128 + u[n].z; sv.w = sv.w * c128 + u[n].w;
  }
  const int e = q >> 5, d4 = (q & 31) * 4;
  float* outp = p.new_ret_prompt + (size_t)bh * 16384;
  outp[(d4 + 0) * 128 + e] = sv.x;
  outp[(d4 + 1) * 128 + e] = sv.y;
  outp[(d4 + 2) * 128 + e] = sv.z;
  outp[(d4 + 3) * 128 + e] = sv.w;
}

DEVINL void r3_item(const Params& p, int id, char* smem) {
  const int tid = get_tid(), lane = tid & 63, wid = tid >> 6, l15 = lane & 15, g4 = lane >> 4;
  const int n = id < 256 ? 15 - (id >> 5) : ((id - 256) >> 5), bh = id & 31, b = bh >> 2, h = bh & 3;
  const int tok0 = b * 2048 + n * 128;
  char* KL = smem;
  char* VL = smem + 32768;
  char* STL = smem + 32768 + 34816;
  const float lg = logf(1.0f - exp2f(-5.0f - (float)h));
  const float c128 = __expf(lg * 128.0f);
#pragma unroll
  for (int i = 0; i < 4; i++) {
    int q = tid + i * 512, j = q >> 4, c = q & 15;
    const u16* rowp = p.Hb + (size_t)(tok0 + j) * 3072;
    *(uint4*)(KL + sw256(j, c)) = *(const uint4*)(p.QKR + (size_t)(tok0 + j) * 1024 + 512 + h * 128 + c * 8);
    *(uint4*)(VL + j * 272 + c * 16) = *(const uint4*)(rowp + 2048 + h * 128 + c * 8);
  }
  {
    const u16* spb = p.SP + (size_t)(bh * 16 + n) * 16384;
#pragma unroll
    for (int i = 0; i < 4; i++) {
      int q = tid + i * 512, e = q >> 4, c = q & 15;
      *(uint4*)(STL + sw256(e, c)) = *(const uint4*)(spb + e * 128 + c * 8);
    }
  }
  const int irow = 16 * wid + l15;
  const u16* qrow = p.Hb + (size_t)(tok0 + irow) * 3072;
  bf16x8 qf[4], qd[4];
  {
    const float qdec = __expf(lg * (float)(irow + 1));
#pragma unroll
    for (int ks = 0; ks < 4; ks++) {
      uint4 raw = *(const uint4*)(p.QKR + (size_t)(tok0 + irow) * 1024 + h * 128 + ks * 32 + 8 * g4);
      qf[ks] = as_frag(raw);
      float x[8]; unpack8(raw, x);
#pragma unroll
      for (int j = 0; j < 8; j++) x[j] *= qdec;
      qd[ks] = as_frag(pack8(x));
    }
  }
  __syncthreads();
  f32x4 pacc[8];
#pragma unroll
  for (int i = 0; i < 8; i++) pacc[i] = (f32x4){0.f, 0.f, 0.f, 0.f};
#pragma unroll
  for (int ks = 0; ks < 4; ks++) {
#pragma unroll
    for (int jt = 0; jt < 8; jt++) {
      if (jt <= wid) {
        bf16x8 kfr = lds_frag(KL + sw256(16 * jt + l15, ks * 4 + g4));
        pacc[jt] = mfma16(kfr, qf[ks], pacc[jt]);
      }
    }
  }
#pragma unroll
  for (int jt = 0; jt < 8; jt++)
#pragma unroll
    for (int r = 0; r < 4; r++) {
      int j = 16 * jt + 4 * g4 + r;
      float v = pacc[jt][r] * __expf(lg * (float)(irow - j));
      pacc[jt][r] = (j <= irow) ? v : 0.f;
    }
  bf16x8 pf[4];
#pragma unroll
  for (int s = 0; s < 4; s++) pf[s] = pack_frag(pacc[2 * s], pacc[2 * s + 1]);
  f32x4 oacc[8];
#pragma unroll
  for (int i = 0; i < 8; i++) oacc[i] = (f32x4){0.f, 0.f, 0.f, 0.f};
#pragma unroll
  for (int s = 0; s < 4; s++) {
    if (2 * s <= wid) {
#pragma unroll
      for (int et = 0; et < 8; et++) {
        bf16x8 vfr = tr_frag_perm(VL, 272, 32 * s, 16 * et, lane);
        oacc[et] = mfma16(vfr, pf[s], oacc[et]);
      }
    }
  }
#pragma unroll
  for (int ks = 0; ks < 4; ks++) {
#pragma unroll
    for (int et = 0; et < 8; et++) {
      bf16x8 sfr = lds_frag(STL + sw256(16 * et + l15, ks * 4 + g4));
      oacc[et] = mfma16(sfr, qd[ks], oacc[et]);
    }
  }
  float sum = 0.f;
#pragma unroll
  for (int et = 0; et < 8; et++) sum += oacc[et][0] + oacc[et][1] + oacc[et][2] + oacc[et][3];
  sum += __shfl_xor(sum, 16); sum += __shfl_xor(sum, 32);
  const float mean = sum * (1.0f / 128.0f);
  float var = 0.f;
#pragma unroll
  for (int et = 0; et < 8; et++)
#pragma unroll
    for (int r = 0; r < 4; r++) { float d = oacc[et][r] - mean; var += d * d; }
  var += __shfl_xor(var, 16); var += __shfl_xor(var, 32);
  const float rstd = rsqrtf(var * (1.0f / 128.0f) + LN_EPS_F);
#pragma unroll
  for (int et = 0; et < 8; et++) {
    int e = 16 * et + 4 * g4;
    float4 gg = *(const float4*)(p.ret_gn_g + h * 128 + e), gb = *(const float4*)(p.ret_gn_b + h * 128 + e);
    uint2 sg = *(const uint2*)(qrow + 2560 + h * 128 + e);
    float o0 = ((oacc[et][0] - mean) * rstd * gg.x + gb.x) * bflo(sg.x);
    float o1 = ((oacc[et][1] - mean) * rstd * gg.y + gb.y) * bfhi(sg.x);
    float o2 = ((oacc[et][2] - mean) * rstd * gg.z + gb.z) * bflo(sg.y);
    float o3 = ((oacc[et][3] - mean) * rstd * gg.w + gb.w) * bfhi(sg.y);
    uint2 o; o.x = pk2(o0, o1); o.y = pk2(o2, o3);
    *(uint2*)(p.MIXIN + (size_t)(tok0 + irow) * 1024 + 512 + h * 128 + e) = o;
  }
  __syncthreads();
}

DEVINL void attn_item(const Params& p, int id, char* smem) {
  const int tid = get_tid(), lane = tid & 63, wid = tid >> 6, l15 = lane & 15, g4 = lane >> 4;
  const bool sample = id >= 512;
  int b, h, tokbase, nvalid;
  if (!sample) { b = id >> 6; h = (id >> 4) & 3; tokbase = b * 2048 + (id & 15) * 128; nvalid = 128; }
  else { int s = id - 512; b = s >> 2; h = s & 3; tokbase = T_P + b * 8; nvalid = 8; }
  if (!sample) {
#pragma unroll 4
    for (int i = 0; i < 16; i++) {
      int q = tid + i * 512, r = q >> 5, c = q & 31;
      *(uint4*)(smem + sw512(r, c)) = *(const uint4*)(p.MemKVb + (size_t)(b * 256 + r) * 2048 + h * 256 + c * 8);
    }
  } else {
#pragma unroll 4
    for (int i = 0; i < 16; i++) {
      int q = tid + i * 512, r = q >> 5, c = q & 31;
      const float* src = p.cache_k + ((size_t)(b * 256 + r) * 4 + h) * 256 + c * 8;
      float4 a = *(const float4*)src, bb = *(const float4*)(src + 4);
      uint4 o; o.x = pk2(a.x, a.y); o.y = pk2(a.z, a.w); o.z = pk2(bb.x, bb.y); o.w = pk2(bb.z, bb.w);
      *(uint4*)(smem + sw512(r, c)) = o;
    }
  }
  __syncthreads();
  const bool active = wid * 16 < nvalid;
  const int irow = wid * 16 + l15;
  const int irc = irow < nvalid ? irow : nvalid - 1;
  const size_t tok = (size_t)(tokbase + irc);
  bf16x8 pf[8];
  float inv_sum = 0.f;
  if (active) {
    const u16* qp = p.QC + tok * 1024 + h * 256 + 8 * g4;
    f32x4 sacc[16];
#pragma unroll
    for (int i = 0; i < 16; i++) sacc[i] = (f32x4){0.f, 0.f, 0.f, 0.f};
    uint4 qcur = *(const uint4*)qp;
#pragma unroll 1
    for (int ks = 0; ks < 8; ks++) {
      uint4 qnext = *(const uint4*)(qp + (ks < 7 ? (ks + 1) * 32 : 0));
      bf16x8 qfr = as_frag(qcur);
#pragma unroll
      for (int mt = 0; mt < 16; mt++) {
        bf16x8 kfr = lds_frag(smem + sw512(16 * mt + l15, ks * 4 + g4));
        sacc[mt] = mfma16(kfr, qfr, sacc[mt]);
      }
      qcur = qnext;
    }
    float mx = -3.0e38f;
#pragma unroll
    for (int mt = 0; mt < 16; mt++)
#pragma unroll
      for (int r = 0; r < 4; r++) mx = fmaxf(mx, sacc[mt][r]);
    mx = fmaxf(mx, __shfl_xor(mx, 16)); mx = fmaxf(mx, __shfl_xor(mx, 32));
    float sum = 0.f;
#pragma unroll
    for (int mt = 0; mt < 16; mt++)
#pragma unroll
      for (int r = 0; r < 4; r++) { float e = __expf(sacc[mt][r] - mx); sacc[mt][r] = e; sum += e; }
    sum += __shfl_xor(sum, 16); sum += __shfl_xor(sum, 32);
    inv_sum = 1.0f / sum;
#pragma unroll
    for (int s = 0; s < 8; s++) pf[s] = pack_frag(sacc[2 * s], sacc[2 * s + 1]);
  }
  __syncthreads();
  if (!sample) {
#pragma unroll 4
    for (int i = 0; i < 16; i++) {
      int q = tid + i * 512, r = q >> 5, c = q & 31;
      *(uint4*)(smem + r * 528 + c * 16) = *(const uint4*)(p.MemKVb + (size_t)(b * 256 + r) * 2048 + 1024 + h * 256 + c * 8);
    }
  } else {
#pragma unroll 4
    for (int i = 0; i < 16; i++) {
      int q = tid + i * 512, r = q >> 5, c = q & 31;
      const float* src = p.cache_v + ((size_t)(b * 256 + r) * 4 + h) * 256 + c * 8;
      float4 a = *(const float4*)src, bb = *(const float4*)(src + 4);
      uint4 o; o.x = pk2(a.x, a.y); o.y = pk2(a.z, a.w); o.z = pk2(bb.x, bb.y); o.w = pk2(bb.z, bb.w);
      *(uint4*)(smem + r * 528 + c * 16) = o;
    }
  }
  __syncthreads();
  if (active) {
    f32x4 oacc[16];
#pragma unroll
    for (int i = 0; i < 16; i++) oacc[i] = (f32x4){0.f, 0.f, 0.f, 0.f};
#pragma unroll
    for (int s = 0; s < 8; s++) {
#pragma unroll
      for (int dt = 0; dt < 16; dt++) {
        bf16x8 vfr = tr_frag_perm(smem, 528, 32 * s, 16 * dt, lane);
        oacc[dt] = mfma16(vfr, pf[s], oacc[dt]);
      }
    }
    if (irow < nvalid) {
#pragma unroll
      for (int dt = 0; dt < 16; dt++) {
        int d = 16 * dt + 4 * g4;
        uint2 o; o.x = pk2(oacc[dt][0] * inv_sum, oacc[dt][1] * inv_sum); o.y = pk2(oacc[dt][2] * inv_sum, oacc[dt][3] * inv_sum);
        *(uint2*)(p.CA + tok * 1024 + h * 256 + d) = o;
      }
    }
  }
  __syncthreads();
}

DEVINL int mono(float f) { int b = __float_as_int(f); return b ^ ((b >> 31) & 0x7fffffff); }
DEVINL float unmono(int k) { return __int_as_float(k ^ ((k >> 31) & 0x7fffffff)); }
#define INS16(top, xv) { int _x = (xv); _Pragma("unroll") for (int _k = 0; _k < 16; _k++) { int _h = max(top[_k], _x); _x = min(top[_k], _x); top[_k] = _h; } }

struct CandTab { int a[64], b[64]; };
constexpr CandTab make_cand_tab() {
  CandTab t{};
  int sl = 0;
  for (int a = 0; a < 16; a++)
    for (int bb = 0; bb < 16; bb++)
      if ((a + 1) * (bb + 1) <= 16) { t.a[sl] = a; t.b[sl] = bb; sl++; }
  for (; sl < 64; sl++) { t.a[sl] = -1; t.b[sl] = -1; }
  return t;
}
constexpr CandTab CT = make_cand_tab();

#define CEX(a, b) { int _mx = max(a, b); int _mn = min(a, b); a = _mx; b = _mn; }
DEVINL void sort16_desc(int (&v)[16]) {
#pragma unroll
  for (int k = 2; k <= 16; k <<= 1) {
#pragma unroll
    for (int j = k >> 1; j > 0; j >>= 1) {
#pragma unroll
      for (int i = 0; i < 16; i++) {
        const int l = i ^ j;
        if (l > i) {
          if ((i & k) == 0) { CEX(v[i], v[l]); } else { CEX(v[l], v[i]); }
        }
      }
    }
  }
}
DEVINL void merge16_desc(int (&a)[16], const int (&b)[16]) {
#pragma unroll
  for (int i = 0; i < 16; i++) a[i] = max(a[i], b[15 - i]);
#pragma unroll
  for (int j = 8; j > 0; j >>= 1) {
#pragma unroll
    for (int i = 0; i < 16; i++) {
      const int l = i ^ j;
      if (l > i) { CEX(a[i], a[l]); }
    }
  }
}

DEVINL void topk_load_q(const Params& p, int t, int wid, int l15, int g4, uint4 (&q)[8]) {
  const int tile = t >> 3, h = t & 7;
  const u16* qp = p.PQ + (size_t)(tile * 128 + 16 * wid + l15) * 2048 + h * 256 + 8 * g4;
#pragma unroll
  for (int c = 0; c < 2; c++)
#pragma unroll
    for (int ks = 0; ks < 4; ks++) q[c * 4 + ks] = *(const uint4*)(qp + c * 128 + ks * 32);
}
DEVINL void topk_half(const float* SCw, int tk, int qt, int (&top)[16]) {
  const float* sp = SCw + (size_t)tk * 132 + qt * 32;
#pragma unroll
  for (int grp = 0; grp < 2; grp++) {
    int v[16];
#pragma unroll
    for (int i = 0; i < 4; i++) {
      f32x4 x = *(const f32x4*)(sp + grp * 16 + i * 4);
#pragma unroll
      for (int r = 0; r < 4; r++) {
        int kidx = qt * 32 + grp * 16 + i * 4 + r;
        v[i * 4 + r] = (mono(x[r]) & ~0x7F) | (127 - kidx);
      }
    }
    sort16_desc(v);
    if (grp == 0) {
#pragma unroll
      for (int k = 0; k < 16; k++) top[k] = v[k];
    } else {
      merge16_desc(top, v);
    }
  }
  int b[16];
#pragma unroll
  for (int k = 0; k < 16; k++) b[k] = __shfl_xor(top[k], 16);
  merge16_desc(top, b);
#pragma unroll
  for (int k = 0; k < 16; k++) b[k] = __shfl_xor(top[k], 32);
  merge16_desc(top, b);
}
DEVINL void peer_topk_phase(const Params& p, char* smem) {
  const int tid = get_tid(), lane = tid & 63, wid = __builtin_amdgcn_readfirstlane(tid >> 6), l15 = lane & 15, g4 = lane >> 4;
  const int bid = blockIdx.x, nb = gridDim.x;
  char* SK = smem;
  float* SCw = (float*)(smem + 65536 + wid * 8448);
  int* LI = (int*)SCw;
  int h_loaded = -1;
  uint4 qn[8];
  if (bid < 1088) topk_load_q(p, bid, wid, l15, g4, qn);
  for (int t = bid; t < 1088; t += nb) {
    const int tile = t >> 3, h = t & 7;
    if (h != h_loaded) {
      __syncthreads();
#pragma unroll
      for (int i = 0; i < 8; i++) {
        int q = tid + i * 512, r = q >> 4, c = q & 15;
        *(uint4*)(SK + sw256(r, c)) = *(const uint4*)(p.SubK + (size_t)(h * 256 + r) * 128 + c * 8);
      }
      __syncthreads();
      h_loaded = h;
    }
    uint4 qc[8];
#pragma unroll
    for (int i = 0; i < 8; i++) qc[i] = qn[i];
    if (t + nb < 1088) topk_load_q(p, t + nb, wid, l15, g4, qn);
    const int tok0 = tile * 128 + 16 * wid;
    const int tk = lane & 15, qt = lane >> 4;
    int m0[16], m1[16];
#pragma unroll
    for (int c = 0; c < 2; c++) {
      f32x4 acc[8];
#pragma unroll
      for (int i = 0; i < 8; i++) acc[i] = (f32x4){0.f, 0.f, 0.f, 0.f};
#pragma unroll
      for (int ks = 0; ks < 4; ks++) {
        bf16x8 qfr = as_frag(qc[c * 4 + ks]);
#pragma unroll
        for (int kt = 0; kt < 8; kt++) {
          bf16x8 kfr = lds_frag(SK + sw256(c * 128 + 16 * kt + l15, ks * 4 + g4));
          acc[kt] = mfma16(kfr, qfr, acc[kt]);
        }
      }
      __builtin_amdgcn_wave_barrier();
#pragma unroll
      for (int kt = 0; kt < 8; kt++) *(f32x4*)(SCw + (size_t)l15 * 132 + 16 * kt + 4 * g4) = acc[kt];
      __builtin_amdgcn_wave_barrier();
      if (c == 0) topk_half(SCw, tk, qt, m0); else topk_half(SCw, tk, qt, m1);
      __builtin_amdgcn_wave_barrier();
    }
    if (qt < 2) {
      int* dst = LI + (qt * 16 + tk) * 17;
#pragma unroll
      for (int k = 0; k < 16; k++) dst[k] = qt ? m1[k] : m0[k];
    }
    int top[16];
    {
      float v0[16], v1[16];
#pragma unroll
      for (int k = 0; k < 16; k++) { v0[k] = unmono(m0[k] & ~0x7F); v1[k] = unmono(m1[k] & ~0x7F); }
#pragma unroll
      for (int k = 0; k < 16; k++) {
        int key[4];
#pragma unroll
        for (int g = 0; g < 4; g++) {
          const int ca = CT.a[g * 16 + k], cb = CT.b[g * 16 + k];
          if (ca >= 0) {
            float sm = v0[ca] + v1[cb];
            key[g] = (mono(sm) & ~0xFF) | (255 - (ca * 16 + cb));
          } else {
            key[g] = (int)0x80000000;
          }
        }
        int lo = (qt & 1) ? key[1] : key[0];
        int hi = (qt & 1) ? key[3] : key[2];
        top[k] = (qt & 2) ? hi : lo;
      }
      sort16_desc(top);
      int b[16];
#pragma unroll
      for (int k = 0; k < 16; k++) b[k] = __shfl_xor(top[k], 16);
      merge16_desc(top, b);
#pragma unroll
      for (int k = 0; k < 16; k++) b[k] = __shfl_xor(top[k], 32);
      merge16_desc(top, b);
    }
    __builtin_amdgcn_wave_barrier();
    if (qt == 0) {
      const int* l0 = LI + (0 * 16 + tk) * 17;
      const int* l1 = LI + (1 * 16 + tk) * 17;
      float fv[16];
      float sum = 0.f;
      const float mx = unmono(top[0] & ~0xFF);
#pragma unroll
      for (int k = 0; k < 16; k++) { fv[k] = __expf(unmono(top[k] & ~0xFF) - mx); sum += fv[k]; }
      const float inv = 1.0f / sum;
      const size_t ob = ((size_t)(tok0 + tk) * 8 + h) * 16;
#pragma unroll
      for (int k = 0; k < 16; k++) {
        int code = 255 - (top[k] & 0xFF);
        int a = code >> 4, bb = code & 15;
        int i0 = 127 - (l0[a] & 0x7F), i1 = 127 - (l1[bb] & 0x7F);
        p.SELI[ob + k] = i0 * 128 + i1;
        p.SELG[ob + k] = fv[k] * inv;
      }
    }
    __builtin_amdgcn_wave_barrier();
  }
}

typedef float f32x2 __attribute__((ext_vector_type(2)));
#define DEC16(q, f) { f32x2 t_; \
  t_ = __builtin_amdgcn_cvt_pk_f32_fp8((int)(q).x, false); f[0] = t_[0]; f[1] = t_[1]; t_ = __builtin_amdgcn_cvt_pk_f32_fp8((int)(q).x, true); f[2] = t_[0]; f[3] = t_[1]; \
  t_ = __builtin_amdgcn_cvt_pk_f32_fp8((int)(q).y, false); f[4] = t_[0]; f[5] = t_[1]; t_ = __builtin_amdgcn_cvt_pk_f32_fp8((int)(q).y, true); f[6] = t_[0]; f[7] = t_[1]; \
  t_ = __builtin_amdgcn_cvt_pk_f32_fp8((int)(q).z, false); f[8] = t_[0]; f[9] = t_[1]; t_ = __builtin_amdgcn_cvt_pk_f32_fp8((int)(q).z, true); f[10] = t_[0]; f[11] = t_[1]; \
  t_ = __builtin_amdgcn_cvt_pk_f32_fp8((int)(q).w, false); f[12] = t_[0]; f[13] = t_[1]; t_ = __builtin_amdgcn_cvt_pk_f32_fp8((int)(q).w, true); f[14] = t_[0]; f[15] = t_[1]; }

#ifndef NFP8
#define NFP8 2
#endif
DEVINL void peer_gather_phase(const Params& p) {
  const int tid_ = get_tid(); const int lane = tid_ & 63, wid = __builtin_amdgcn_readfirstlane(tid_ >> 6);
  const int kl = ((lane >> 5) & 1) * 8 + ((lane >> 4) & 1) * 4 + ((lane >> 3) & 1) * 2 + ((lane >> 2) & 1);
  for (int t = blockIdx.x * 8 + wid; t < T_ALL; t += gridDim.x * 8) {
    float x[16], out[16];
    {
      const u16* xr = p.Xb + (size_t)t * 1024 + lane * 16;
      uint4 a = *(const uint4*)xr, b = *(const uint4*)(xr + 8);
      unpack8(a, x); unpack8(b, x + 8);
    }
    float out4[16];
    float sumck = 0.f;
#pragma unroll
    for (int j = 0; j < 16; j++) { out[j] = 0.f; out4[j] = 0.f; }
    int xp[2][2];
    float xs;
    {
      float am = 0.f;
#pragma unroll
      for (int j = 0; j < 16; j++) am = fmaxf(am, fabsf(x[j]));
#pragma unroll
      for (int o = 32; o >= 1; o >>= 1) am = fmaxf(am, __shfl_xor(am, o));
      const float xinv = am > 0.f ? 118.0f / am : 0.f;
      xs = am > 0.f ? am / 118.0f : 0.f;
      unsigned pl[2][2] = {{0u, 0u}, {0u, 0u}};
#pragma unroll
      for (int j = 0; j < 16; j++) {
        const int xi = (int)rintf(x[j] * xinv);
        const int n0 = ((xi + 8) & 15) - 8;
        const int n1 = (xi - n0) >> 4;
        pl[0][j >> 3] |= ((unsigned)n0 & 15u) << (4 * (j & 7));
        pl[1][j >> 3] |= ((unsigned)n1 & 15u) << (4 * (j & 7));
      }
#pragma unroll
      for (int q = 0; q < 2; q++) { xp[q][0] = (int)pl[q][0]; xp[q][1] = (int)pl[q][1]; }
    }
#pragma unroll 1
    for (int h = 0; h < 8; h++) {
      const size_t sb = ((size_t)t * 8 + h) * 16;
      const int ei = p.SELI[sb + (lane & 15)];
      const int ekl = p.SELI[sb + kl];
      const float gk = p.SELG[sb + kl];
      const float us = p.Usc[ekl] * xs, vs = (kl >= NFP8) ? p.Vsc4[ekl] : p.Vsc[ekl];
      float part[16];
      {
        uint2 u[16];
#pragma unroll
        for (int k = 0; k < 16; k++) {
          int e = __builtin_amdgcn_readlane(ei, k);
          u[k] = *(const uint2*)(p.Ub4 + (size_t)e * 512 + lane * 8);
        }
#pragma unroll
        for (int k = 0; k < 16; k++) {
          const int d0 = __builtin_amdgcn_sdot8((int)u[k].x, xp[0][0], __builtin_amdgcn_sdot8((int)u[k].y, xp[0][1], 0, false), false);
          const int d1 = __builtin_amdgcn_sdot8((int)u[k].x, xp[1][0], __builtin_amdgcn_sdot8((int)u[k].y, xp[1][1], 0, false), false);
          part[k] = (float)(d0 + 16 * d1);
        }
      }
      float p8[8], p4[4], p2[2], z;
      {
        const bool hi = (lane & 32) != 0;
#pragma unroll
        for (int k = 0; k < 8; k++) {
          float send = hi ? part[k] : part[k + 8];
          float keep = hi ? part[k + 8] : part[k];
          p8[k] = keep + __shfl_xor(send, 32);
        }
      }
      {
        const bool hi = (lane & 16) != 0;
#pragma unroll
        for (int k = 0; k < 4; k++) {
          float send = hi ? p8[k] : p8[k + 4];
          float keep = hi ? p8[k + 4] : p8[k];
          p4[k] = keep + __shfl_xor(send, 16);
        }
      }
      {
        const bool hi = (lane & 8) != 0;
#pragma unroll
        for (int k = 0; k < 2; k++) {
          float send = hi ? p4[k] : p4[k + 2];
          float keep = hi ? p4[k + 2] : p4[k];
          p2[k] = keep + __shfl_xor(send, 8);
        }
      }
      {
        const bool hi = (lane & 4) != 0;
        float send = hi ? p2[0] : p2[1];
        float keep = hi ? p2[1] : p2[0];
        z = keep + __shfl_xor(send, 4);
      }
      z += __shfl_xor(z, 1);
      z += __shfl_xor(z, 2);
      const float co = gk * gelu_tanh(z * us) * vs;
      {
        uint4 v[NFP8];
#pragma unroll
        for (int k = 0; k < NFP8; k++) {
          int e = __builtin_amdgcn_readlane(ei, k);
          v[k] = *(const uint4*)(p.Vb8 + (size_t)e * 1024 + lane * 16);
        }
#pragma unroll
        for (int k = 0; k < NFP8; k++) {
          const int src = ((k >> 3) & 1) * 32 + ((k >> 2) & 1) * 16 + ((k >> 1) & 1) * 8 + (k & 1) * 4;
          const float ck = __int_as_float(__builtin_amdgcn_readlane(__float_as_int(co), src));
          float f[16];
          DEC16(v[k], f);
#pragma unroll
          for (int j = 0; j < 16; j++) out[j] += ck * f[j];
        }
        __builtin_amdgcn_sched_barrier(0);
      }
      {
        uint2 v[16 - NFP8];
#pragma unroll
        for (int k = 0; k < 16 - NFP8; k++) {
          int e = __builtin_amdgcn_readlane(ei, NFP8 + k);
          v[k] = *(const uint2*)(p.Vb4 + (size_t)e * 512 + lane * 8);
        }
#pragma unroll
        for (int k = 0; k < 16 - NFP8; k++) {
          const int kk = NFP8 + k;
          const int src = ((kk >> 3) & 1) * 32 + ((kk >> 2) & 1) * 16 + ((kk >> 1) & 1) * 8 + (kk & 1) * 4;
          const float ck = __int_as_float(__builtin_amdgcn_readlane(__float_as_int(co), src));
          const unsigned ckb = pk2(ck, 0.f) & 0xffffu;
          union { unsigned u; bf16v2 h; } blo, bhi, tt;
          blo.u = ckb; bhi.u = ckb << 16;
          sumck += __uint_as_float(ckb << 16);
#pragma unroll
          for (int w = 0; w < 2; w++) {
            const unsigned wd = w ? v[k].y : v[k].x;
#pragma unroll
            for (int i = 0; i < 4; i++) {
              tt.u = ((wd >> (4 * i)) & 0x000F000Fu) | 0x43004300u;
              out4[8 * w + i] = __builtin_amdgcn_fdot2_f32_bf16(tt.h, blo.h, out4[8 * w + i], false);
              out4[8 * w + i + 4] = __builtin_amdgcn_fdot2_f32_bf16(tt.h, bhi.h, out4[8 * w + i + 4], false);
            }
          }
        }
        __builtin_amdgcn_sched_barrier(0);
      }
    }
#pragma unroll
    for (int j = 0; j < 16; j++) out[j] += out4[j] - 136.0f * sumck;
    float s = 0.f;
#pragma unroll
    for (int j = 0; j < 16; j++) { out[j] = ALPHA_F * x[j] + out[j]; s += out[j]; }
    const float mean = wave_sum(s) * (1.0f / 1024.0f);
    float q = 0.f;
#pragma unroll
    for (int j = 0; j < 16; j++) { float d = out[j] - mean; q += d * d; }
    const float rstd = rsqrtf(wave_sum(q) * (1.0f / 1024.0f) + LN_EPS_F);
    float* yr = p.Y + (size_t)t * 1024 + lane * 16;
    const float* gp = p.ln3_g + lane * 16;
    const float* bp = p.ln3_b + lane * 16;
#pragma unroll
    for (int i = 0; i < 4; i++) {
      float4 g = *(const float4*)(gp + i * 4), b = *(const float4*)(bp + i * 4);
      float4 y;
      y.x = (out[i * 4 + 0] - mean) * rstd * g.x + b.x; y.y = (out[i * 4 + 1] - mean) * rstd * g.y + b.y;
      y.z = (out[i * 4 + 2] - mean) * rstd * g.z + b.z; y.w = (out[i * 4 + 3] - mean) * rstd * g.w + b.w;
      *(float4*)(yr + i * 4) = y;
    }
  }
}

struct KArgs { const float* in[28]; float* out; char* ws; int flags; int pad; };

constexpr size_t al256(size_t b) { return (b + 255) & ~(size_t)255; }
constexpr size_t OFF_BAR = 0;
constexpr size_t OFF_WINT = OFF_BAR + 16384;
constexpr size_t OFF_WOT = OFF_WINT + al256((size_t)3072 * 1024 * 2);
constexpr size_t OFF_WQT = OFF_WOT + al256((size_t)1024 * 1024 * 2);
constexpr size_t OFF_WKVT = OFF_WQT + al256((size_t)1024 * 1024 * 2);
constexpr size_t OFF_WCOT = OFF_WKVT + al256((size_t)2048 * 1024 * 2);
constexpr size_t OFF_PWQT = OFF_WCOT + al256((size_t)1024 * 1024 * 2);
constexpr size_t OFF_SUBK = OFF_PWQT + al256((size_t)2048 * 1024 * 2);
constexpr size_t OFF_UB = OFF_SUBK + al256((size_t)262144 * 2);
constexpr size_t OFF_VB = OFF_UB + al256((size_t)16384 * 1024 * 2);
constexpr size_t OFF_XB = OFF_VB + al256((size_t)16384 * 1024 * 2);
constexpr size_t OFF_MEMB = OFF_XB + al256((size_t)T_ALL * 1024 * 2);
constexpr size_t OFF_HB = OFF_MEMB + al256((size_t)2048 * 1024 * 2);
constexpr size_t OFF_MEMKVB = OFF_HB + al256((size_t)T_ALL * 3072 * 2);
constexpr size_t OFF_RCOS = OFF_MEMKVB + al256((size_t)2048 * 2048 * 2);
constexpr size_t OFF_RSIN = OFF_RCOS + al256((size_t)2056 * 64 * 4);
constexpr size_t OFF_U = OFF_RSIN + al256((size_t)2056 * 64 * 4);
constexpr size_t OFF_MIXIN = OFF_U + al256((size_t)512 * 16384 * 4);
constexpr size_t OFF_PRE = OFF_MIXIN + al256((size_t)T_ALL * 1024 * 2);
constexpr size_t OFF_XF = OFF_PRE + al256((size_t)T_ALL * 1024 * 4);
constexpr size_t OFF_SELI = OFF_XF + al256((size_t)T_ALL * 1024 * 4);
constexpr size_t OFF_SELG = OFF_SELI + al256((size_t)T_ALL * 128 * 4);
constexpr size_t OFF_QKR = OFF_SELG + al256((size_t)T_ALL * 128 * 4);
constexpr size_t WS_TOTAL = OFF_QKR + al256((size_t)T_P * 1024 * 2);

DEVINL Params make_view(const KArgs& ka) {
  Params p;
  p.x_prompt = ka.in[0]; p.x_sample = ka.in[1]; p.mem_prompt = ka.in[2]; p.cache_k = ka.in[3]; p.cache_v = ka.in[4]; p.state_ret = ka.in[5];
  p.w_in = ka.in[6]; p.w_s = ka.in[7]; p.b_s = ka.in[8]; p.gate_ln_g = ka.in[9]; p.gate_ln_b = ka.in[10]; p.ret_gn_g = ka.in[11];
  p.ret_gn_b = ka.in[12]; p.w_o = ka.in[13]; p.ln1_g = ka.in[14]; p.ln1_b = ka.in[15]; p.ca_wq = ka.in[16]; p.ca_wk = ka.in[17];
  p.ca_wv = ka.in[18]; p.ca_wo = ka.in[19]; p.ln2_g = ka.in[20]; p.ln2_b = ka.in[21]; p.peer_wq = ka.in[22]; p.peer_subkeys = ka.in[23];
  p.peer_u = ka.in[24]; p.peer_v = ka.in[25]; p.ln3_g = ka.in[26]; p.ln3_b = ka.in[27];
  float* o = ka.out;
  p.Y = o;
  p.new_mem_k = o + (size_t)T_ALL * 1024;
  p.new_mem_v = p.new_mem_k + (size_t)2048 * 1024;
  p.new_ret_prompt = p.new_mem_v + (size_t)2048 * 1024;
  p.new_ret_sample = p.new_ret_prompt + (size_t)32 * 16384;
  p.new_gate_v = p.new_ret_sample + (size_t)512 * 16384;
  char* w = ka.ws;
  p.bar = (unsigned*)(w + OFF_BAR);
  p.WinT = (u16*)(w + OFF_WINT); p.WoT = (u16*)(w + OFF_WOT); p.WqT = (u16*)(w + OFF_WQT); p.WkvT = (u16*)(w + OFF_WKVT);
  p.WcoT = (u16*)(w + OFF_WCOT); p.PwqT = (u16*)(w + OFF_PWQT); p.SubK = (u16*)(w + OFF_SUBK); p.Ub = (u16*)(w + OFF_UB);
  p.Vb = (u16*)(w + OFF_VB);
  p.Ub8 = (unsigned char*)(w + OFF_UB); p.Ub4 = p.Ub8; p.Usc = (float*)(w + OFF_UB + (size_t)16384 * 1024);
  p.Vb8 = (unsigned char*)(w + OFF_VB); p.Vsc = (float*)(w + OFF_VB + (size_t)16384 * 1024);
  p.Vb4 = (unsigned char*)(w + OFF_VB + (size_t)20 * 1024 * 1024); p.Vsc4 = (float*)(w + OFF_VB + (size_t)30 * 1024 * 1024); p.Xb = (u16*)(w + OFF_XB); p.Memb = (u16*)(w + OFF_MEMB); p.Hb = (u16*)(w + OFF_HB);
  p.QC = p.Hb; p.PQ = p.Hb + (size_t)T_ALL * 1024;
  p.MemKVb = (u16*)(w + OFF_MEMKVB); p.rope_cos = (float*)(w + OFF_RCOS); p.rope_sin = (float*)(w + OFF_RSIN);
  p.U = (float*)(w + OFF_U); p.MIXIN = (u16*)(w + OFF_MIXIN); p.CA = p.MIXIN; p.PREb = (u16*)(w + OFF_PRE); p.SP = (u16*)(w + OFF_XF);
  p.SELI = (int*)(w + OFF_SELI); p.SELG = (float*)(w + OFF_SELG); p.QKR = (u16*)(w + OFF_QKR);
  return p;
}

__global__ void __launch_bounds__(NT) fwd_megakernel(KArgs ka) {
  __shared__ __attribute__((aligned(16))) char smem[SMEM_BYTES];
  __shared__ uint4 xb_words;
  if (threadIdx.x == 0) xb_words = make_uint4(0u, 0u, 0u, 0u);
  __syncthreads();
  const Params p = make_view(ka);
  XcdBarrier xb = xcd_barrier_post(p.bar, (volatile LAS unsigned*)&xb_words);
  const int bid = blockIdx.x, nb = gridDim.x;
  unsigned epoch = 0;

#if PH(0)
  RPT(0) prep_phase(p, smem);
#endif
  if (ka.flags & 1) cg::this_grid().sync();
  grid_barrier(p, epoch);

#if PH(1)
  {
    gemm_run<256>(p.Xb, p.WinT, bid, 1632, nb, [&](int t, int& m0, int& n0) { int mt = t / 12; m0 = mt * 128; n0 = (t - mt * 12) * 256; }, smem,
      [&](int m, int n, f32x4 v) {
        if (n < 1024) { v[0] = gelu_tanh(v[0]); v[1] = gelu_tanh(v[1]); v[2] = gelu_tanh(v[2]); v[3] = gelu_tanh(v[3]); }
        else if (n >= 2560) { v[0] = silu_f(v[0]); v[1] = silu_f(v[1]); v[2] = silu_f(v[2]); v[3] = silu_f(v[3]); }
        uint2 o; o.x = pk2(v[0], v[1]); o.y = pk2(v[2], v[3]);
        *(uint2*)(p.Hb + (size_t)m * 3072 + n) = o;
      });
    gemm_run<256>(p.Memb, p.WkvT, first_ge(bid, nb, 1632), 1760, nb, [&](int t, int& m0, int& n0) { int u = t - 1632; m0 = (u >> 3) * 128; n0 = (u & 7) * 256; }, smem,
      [&](int m, int n, f32x4 v) {
        float* dst = (n < 1024) ? (p.new_mem_k + (size_t)m * 1024 + n) : (p.new_mem_v + (size_t)m * 1024 + (n - 1024));
        *(f32x4*)dst = v;
        uint2 o; o.x = pk2(v[0], v[1]); o.y = pk2(v[2], v[3]);
        *(uint2*)(p.MemKVb + (size_t)m * 2048 + n) = o;
      });
  }
#endif
  grid_barrier(p, epoch);

#if PH(2)
  RPT(2) for (int t = bid; t < 1664; t += nb) {
    if (t < 512) r1_item(p, t, smem);
    else if (t < 1024) gate_prompt_item(p, t - 512, smem);
    else if (t < 1536) ret_sample_item(p, t - 1024, smem);
    else gate_sample_item(p, t - 1536, smem);
  }
#endif
  grid_barrier(p, epoch);

  for (int t = bid; t < 256; t += nb) ret_scan_item(p, t);
  grid_barrier(p, epoch);

#if PH(3)
  RPT(3) for (int t = bid; t < 512; t += nb) r3_item(p, t, smem);
#endif
  grid_barrier(p, epoch);

#if PH(4)
  {
    auto epi4 = [&](int m, int n, f32x4 v) {
      float4 xr = *(const float4*)(xin_row(p, m) + n);
      uint2 o; o.x = pk2(ALPHA_F * xr.x + v[0], ALPHA_F * xr.y + v[1]); o.y = pk2(ALPHA_F * xr.z + v[2], ALPHA_F * xr.w + v[3]);
      *(uint2*)(p.PREb + (size_t)m * 1024 + n) = o;
    };
    gemm_run<256>(p.MIXIN, p.WoT, bid, 512, nb, [&](int t, int& m0, int& n0) { m0 = (t >> 2) * 128; n0 = (t & 3) * 256; }, smem, epi4);
    gemm_run<128>(p.MIXIN, p.WoT, first_ge(bid, nb, 512), 576, nb, [&](int t, int& m0, int& n0) { int u = t - 512; m0 = (128 + (u >> 3)) * 128; n0 = (u & 7) * 128; }, smem, epi4);
    if (bid >= 64) quant_rows(p, 0, 10923, bid - 64, nb - 64);
  }
#endif
  grid_barrier(p, epoch);

  RPT(5) ln_phase(p.PREb, p.ln1_g, p.ln1_b, p.Xb);
  grid_barrier(p, epoch);

#if PH(6)
  {
    auto epi6 = [&](int m, int n, f32x4 v) {
      uint2 o; o.x = pk2(v[0] * 0.0625f, v[1] * 0.0625f); o.y = pk2(v[2] * 0.0625f, v[3] * 0.0625f);
      *(uint2*)(p.QC + (size_t)m * 1024 + n) = o;
    };
    gemm_run<256>(p.Xb, p.WqT, bid, 512, nb, [&](int t, int& m0, int& n0) { m0 = (t >> 2) * 128; n0 = (t & 3) * 256; }, smem, epi6);
    gemm_run<128>(p.Xb, p.WqT, first_ge(bid, nb, 512), 576, nb, [&](int t, int& m0, int& n0) { int u = t - 512; m0 = (128 + (u >> 3)) * 128; n0 = (u & 7) * 128; }, smem, epi6);
    if (bid >= 64) quant_rows(p, 10923, 21846, bid - 64, nb - 64);
  }
#endif
  grid_barrier(p, epoch);

#if PH(7)
  if ((nb & 1) == 0) {
    const int half = nb >> 1, hb = bid >> 1;
    if ((bid & 1) == 0) { for (int t = hb; t < 512; t += half) attn_item(p, t, smem); }
    else { for (int t = hb; t < 512; t += half) attn_item(p, 512 + t, smem); }
  } else {
    for (int t = bid; t < 1024; t += nb) attn_item(p, t, smem);
  }
#endif
  grid_barrier(p, epoch);

#if PH(8)
  {
    auto epi8 = [&](int m, int n, f32x4 v) {
      uint2 xr = *(const uint2*)(p.Xb + (size_t)m * 1024 + n);
      uint2 o; o.x = pk2(ALPHA_F * bflo(xr.x) + v[0], ALPHA_F * bfhi(xr.x) + v[1]); o.y = pk2(ALPHA_F * bflo(xr.y) + v[2], ALPHA_F * bfhi(xr.y) + v[3]);
      *(uint2*)(p.PREb + (size_t)m * 1024 + n) = o;
    };
    gemm_run<256>(p.CA, p.WcoT, bid, 512, nb, [&](int t, int& m0, int& n0) { m0 = (t >> 2) * 128; n0 = (t & 3) * 256; }, smem, epi8);
    gemm_run<128>(p.CA, p.WcoT, first_ge(bid, nb, 512), 576, nb, [&](int t, int& m0, int& n0) { int u = t - 512; m0 = (128 + (u >> 3)) * 128; n0 = (u & 7) * 128; }, smem, epi8);
    if (bid >= 64) quant_rows(p, 21846, 32768, bid - 64, nb - 64);
  }
#endif
  grid_barrier(p, epoch);

  RPT(9) ln_phase(p.PREb, p.ln2_g, p.ln2_b, p.Xb);
  grid_barrier(p, epoch);

#if PH(10)
  {
    auto epi10 = [&](int m, int n, f32x4 v) {
      uint2 o; o.x = pk2(v[0], v[1]); o.y = pk2(v[2], v[3]);
      *(uint2*)(p.PQ + (size_t)m * 2048 + n) = o;
    };
    gemm_run<256>(p.Xb, p.PwqT, bid, 1024, nb, [&](int t, int& m0, int& n0) { m0 = (t >> 3) * 128; n0 = (t & 7) * 256; }, smem, epi10);
    gemm_run<128>(p.Xb, p.PwqT, first_ge(bid, nb, 1024), 1152, nb, [&](int t, int& m0, int& n0) { int u = t - 1024; m0 = (128 + (u >> 4)) * 128; n0 = (u & 15) * 128; }, smem, epi10);
  }
#endif
  grid_barrier(p, epoch);

#if PH(11)
  __syncthreads();
  RPT(11) peer_topk_phase(p, smem);
#endif
  grid_barrier(p, epoch);

#if PH(12)
  RPT(12) peer_gather_phase(p);
#endif
}

extern "C" void kernel_launch(void* const* d_in, const int* in_sizes, int n_in, void* d_out, int out_size, void* d_ws,
                              size_t ws_size, hipStream_t stream) {
  (void)in_sizes; (void)n_in; (void)out_size;
  KArgs ka;
  memset(&ka, 0, sizeof(ka));
  for (int i = 0; i < 28; i++) ka.in[i] = (const float*)d_in[i];
  ka.out = (float*)d_out;
  ka.ws = (char*)d_ws;
  if (ws_size < WS_TOTAL) fprintf(stderr, "workspace too small: %zu < %zu\n", ws_size, (size_t)WS_TOTAL);
  static int grid_blocks = 0;
  if (!grid_blocks) {
    int dev = 0, cus = 0, per_cu = 0;
    hipGetDevice(&dev);
    hipDeviceGetAttribute(&cus, hipDeviceAttributeMultiprocessorCount, dev);
    hipOccupancyMaxActiveBlocksPerMultiprocessor(&per_cu, fwd_megakernel, NT, 0);
    if (per_cu < 1) per_cu = 1;
    if (per_cu > 1) per_cu = 1;
    grid_blocks = cus * per_cu;
  }
  hipMemsetAsync(ka.ws + OFF_BAR, 0, XCD_BAR_WORDS * 4, stream);
  void* args[] = {&ka};
  hipError_t e = hipLaunchCooperativeKernel((void*)fwd_megakernel, dim3(grid_blocks), dim3(NT), args, 0, stream);
  if (e != hipSuccess) fprintf(stderr, "cooperative launch failed: %s (grid %d)\n", hipGetErrorString(e), grid_blocks);
}
```

```cpp
#include <hip/hip_runtime.h>
#include <hip/hip_cooperative_groups.h>
#include <cstdio>
#include <cstdint>
#include <cstring>
namespace cg = cooperative_groups;

#define NT 512
#define DEVINL __device__ __forceinline__
#ifndef PHASES
#define PHASES 0xFFFF
#endif
#define PH(k) ((PHASES >> (k)) & 1)
#ifndef RPT_MASK
#define RPT_MASK 0x0
#endif
#define RPT(k) for (int rep_ = 0; rep_ < 1 + ((RPT_MASK >> (k)) & 1); rep_++)
#ifndef USE_CG_SYNC
#define USE_CG_SYNC 0
#endif

typedef unsigned short u16;
typedef short bf16x8 __attribute__((ext_vector_type(8)));
typedef short s4v __attribute__((ext_vector_type(4)));
typedef float f32x4 __attribute__((ext_vector_type(4)));

constexpr int T_ALL = 17408;
constexpr int T_P = 16384;
constexpr float ALPHA_F = 1.189207115002721f;
constexpr float LN_EPS_F = 1e-5f;
constexpr int SMEM_BYTES = 139264;

struct Params {
  const float *x_prompt, *x_sample, *mem_prompt, *cache_k, *cache_v, *state_ret, *w_in, *w_s, *b_s,
      *gate_ln_g, *gate_ln_b, *ret_gn_g, *ret_gn_b, *w_o, *ln1_g, *ln1_b, *ca_wq, *ca_wk, *ca_wv, *ca_wo,
      *ln2_g, *ln2_b, *peer_wq, *peer_subkeys, *peer_u, *peer_v, *ln3_g, *ln3_b;
  float *Y, *new_mem_k, *new_mem_v, *new_ret_prompt, *new_ret_sample, *new_gate_v;
  unsigned char *Ub8, *Vb8, *Ub4, *Vb4;
  float* Vsc4;
  float *Usc, *Vsc;
  u16 *QKR, *WinT, *WoT, *WqT, *WkvT, *WcoT, *PwqT, *SubK, *Ub, *Vb, *Xb, *Memb, *Hb, *MemKVb, *MIXIN, *QC, *CA, *PQ;
  float *rope_cos, *rope_sin, *U, *SELG;
  u16* PREb;
  u16* SP;
  int* SELI;
  unsigned* bar;
};

typedef __bf16 bf16v2 __attribute__((ext_vector_type(2)));
typedef float f32v2 __attribute__((ext_vector_type(2)));
DEVINL unsigned pk2(float a, float b) {
  f32v2 v = {a, b};
  union { bf16v2 h; unsigned u; } c;
  c.h = __builtin_convertvector(v, bf16v2);
  return c.u;
}
DEVINL u16 f2bf(float f) { return (u16)(pk2(f, 0.f) & 0xffffu); }
DEVINL float bflo(unsigned u) { return __uint_as_float(u << 16); }
DEVINL float bfhi(unsigned u) { return __uint_as_float(u & 0xffff0000u); }
DEVINL float bf1(u16 h) { return __uint_as_float(((unsigned)h) << 16); }
DEVINL void unpack8(const uint4& r, float* x) {
  x[0] = bflo(r.x); x[1] = bfhi(r.x); x[2] = bflo(r.y); x[3] = bfhi(r.y);
  x[4] = bflo(r.z); x[5] = bfhi(r.z); x[6] = bflo(r.w); x[7] = bfhi(r.w);
}
DEVINL uint4 pack8(const float* x) {
  uint4 o; o.x = pk2(x[0], x[1]); o.y = pk2(x[2], x[3]); o.z = pk2(x[4], x[5]); o.w = pk2(x[6], x[7]);
  return o;
}
DEVINL bf16x8 as_frag(const uint4& r) {
  union { uint4 u; bf16x8 f; } c; c.u = r; return c.f;
}
DEVINL f32x4 mfma16(bf16x8 a, bf16x8 b, f32x4 c) { return __builtin_amdgcn_mfma_f32_16x16x32_bf16(a, b, c, 0, 0, 0); }
DEVINL float gelu_tanh(float x) {
  float u = 0.7978845608028654f * (x + 0.044715f * x * x * x);
  float e = __expf(2.0f * u);
  float t = 1.0f - 2.0f * __builtin_amdgcn_rcpf(e + 1.0f);
  return 0.5f * x * (1.0f + t);
}
DEVINL float silu_f(float x) { return x * __builtin_amdgcn_rcpf(1.0f + __expf(-x)); }
DEVINL int sw128(int r, int c) { return r * 128 + ((c ^ (r & 7)) << 4); }
DEVINL int sw256(int r, int c) { return r * 256 + ((c ^ (r & 15)) << 4); }
DEVINL int sw512(int r, int c) { return r * 512 + ((c ^ (r & 15)) << 4); }
DEVINL bf16x8 lds_frag(const char* p) { return *(const bf16x8*)p; }
DEVINL s4v tr_read(const char* p) {
  return __builtin_amdgcn_ds_read_tr16_b64_v4i16((__attribute__((address_space(3))) s4v*)p);
}
DEVINL bf16x8 tr_frag(const char* base, int stride, int k0, int c0, int lane) {
  int grp = lane >> 4, q = (lane >> 2) & 3, pp = lane & 3;
  const char* a0 = base + (k0 + 8 * grp + q) * stride + (c0 + 4 * pp) * 2;
  s4v lo = tr_read(a0), hi = tr_read(a0 + 4 * stride);
  bf16x8 r; r[0] = lo[0]; r[1] = lo[1]; r[2] = lo[2]; r[3] = lo[3]; r[4] = hi[0]; r[5] = hi[1]; r[6] = hi[2]; r[7] = hi[3];
  return r;
}
DEVINL bf16x8 tr_frag_perm(const char* base, int stride, int k0, int c0, int lane) {
  int grp = lane >> 4, q = (lane >> 2) & 3, pp = lane & 3;
  const char* a0 = base + (k0 + 4 * grp + q) * stride + (c0 + 4 * pp) * 2;
  s4v lo = tr_read(a0), hi = tr_read(a0 + 16 * stride);
  bf16x8 r; r[0] = lo[0]; r[1] = lo[1]; r[2] = lo[2]; r[3] = lo[3]; r[4] = hi[0]; r[5] = hi[1]; r[6] = hi[2]; r[7] = hi[3];
  return r;
}
DEVINL bf16x8 pack_frag(const f32x4& a, const f32x4& b) {
  uint4 o; o.x = pk2(a[0], a[1]); o.y = pk2(a[2], a[3]); o.z = pk2(b[0], b[1]); o.w = pk2(b[2], b[3]);
  return as_frag(o);
}
DEVINL float wave_sum(float v) {
#pragma unroll
  for (int o = 32; o >= 1; o >>= 1) v += __shfl_xor(v, o);
  return v;
}
DEVINL const float* xin_row(const Params& p, int m) {
  return (m < T_P) ? (p.x_prompt + (size_t)m * 1024) : (p.x_sample + (size_t)(m - T_P) * 1024);
}

DEVINL int get_tid() { int t = threadIdx.x; asm volatile("" : "+v"(t)); return t; }

#define XB_TMO      128
#define XB_XCNT(j)  (256  + 64 * (j))
#define XB_XSUB(j)  (1280 + 64 * (j))
#define XB_XGEN(j)  (2304 + 64 * (j))
#define XB_TOP      3328
#define XB_TOPGEN   3392
#define XCD_BAR_WORDS 3456
#define XB_SPIN_CAP (1u << 22)
#define LAS __attribute__((address_space(3)))
DEVINL unsigned xb_ld(unsigned* p) { return __hip_atomic_load(p, __ATOMIC_RELAXED, __HIP_MEMORY_SCOPE_AGENT); }
DEVINL unsigned xb_add(unsigned* p, unsigned v) { return __hip_atomic_fetch_add(p, v, __ATOMIC_RELAXED, __HIP_MEMORY_SCOPE_AGENT); }
DEVINL unsigned xb_xcc_id() { return (unsigned)__builtin_amdgcn_s_getreg((3 << 11) | 20) & 0xFu; }
#define XB_SPIN(cond, bar) do { unsigned _sp = 0; while (cond) { __builtin_amdgcn_s_sleep(1); \
    if ((++_sp & 255u) == 0u) { if (xb_ld(&(bar)[XB_TMO])) break; if (_sp > XB_SPIN_CAP) { atomicAdd(&(bar)[XB_TMO], 1u); break; } } } } while (0)
struct XcdBarrier { unsigned* bar; unsigned x; volatile LAS unsigned* st; };
DEVINL XcdBarrier xcd_barrier_post(unsigned* bar, volatile LAS unsigned* st) {
  XcdBarrier b; b.bar = bar; b.x = xb_xcc_id(); b.st = st;
  if (threadIdx.x == 0) (void)xb_add(&bar[XB_XCNT(b.x)], 1u);
  return b;
}
DEVINL void xcd_barrier_complete(unsigned* bar, unsigned x, unsigned& nloc, unsigned& nx) {
  const unsigned G = gridDim.x * gridDim.y * gridDim.z;
  unsigned sum, cnt, mine, sp = 0u;
  for (;;) {
    sum = 0u; cnt = 0u; mine = 0u;
#pragma unroll
    for (unsigned j = 0; j < 16; ++j) { const unsigned c = xb_ld(&bar[XB_XCNT(j)]); sum += c; cnt += (c > 0u) ? 1u : 0u; mine = (j == x) ? c : mine; }
    if (sum == G) break;
    __builtin_amdgcn_s_sleep(1);
    if ((++sp & 255u) == 0u) { if (xb_ld(&bar[XB_TMO])) break; if (sp > XB_SPIN_CAP) { atomicAdd(&bar[XB_TMO], 1u); break; } }
  }
  nloc = mine > 0u ? mine : 1u; nx = cnt > 0u ? cnt : 1u;
}
DEVINL void xcd_barrier(const XcdBarrier& b) {
  asm volatile("s_waitcnt vmcnt(0)" ::: "memory");
  __syncthreads();
  if (threadIdx.x == 0) {
    unsigned* bar = b.bar;
    __builtin_amdgcn_s_waitcnt(0);
    unsigned nloc = b.st[0], nx = b.st[1];
    if (nloc == 0u) { xcd_barrier_complete(bar, b.x, nloc, nx); b.st[0] = nloc; b.st[1] = nx; }
    const unsigned old = xb_add(&bar[XB_XSUB(b.x)], 1u);
    const unsigned gen = old / nloc;
    if (old + 1u == (gen + 1u) * nloc) {
      __builtin_amdgcn_fence(__ATOMIC_RELEASE, "agent");
      asm volatile("s_waitcnt vmcnt(0)" ::: "memory");
      const unsigned og = xb_add(&bar[XB_TOP], 1u);
      const unsigned tg = og / nx;
      if (og + 1u == (tg + 1u) * nx) xb_add(&bar[XB_TOPGEN], 1u);
      else XB_SPIN(xb_ld(&bar[XB_TOPGEN]) == tg, bar);
      __builtin_amdgcn_fence(__ATOMIC_ACQUIRE, "agent");
      xb_add(&bar[XB_XGEN(b.x)], 1u);
      asm volatile("s_waitcnt vmcnt(0)" ::: "memory");
    } else {
      XB_SPIN(xb_ld(&bar[XB_XGEN(b.x)]) == gen, bar);
      __builtin_amdgcn_fence(__ATOMIC_ACQUIRE, "agent");
      asm volatile("s_waitcnt vmcnt(0)" ::: "memory");
    }
  }
  __syncthreads();
}
#define grid_barrier(p, epoch) xcd_barrier(xb)

DEVINL void cvt_range(const float* __restrict__ src, u16* __restrict__ dst, size_t n8) {
  size_t stride = (size_t)gridDim.x * NT;
  const int tid_ = get_tid();
  for (size_t i = (size_t)blockIdx.x * NT + tid_; i < n8; i += stride) {
    float4 a = ((const float4*)src)[2 * i], b = ((const float4*)src)[2 * i + 1];
    uint4 o; o.x = pk2(a.x, a.y); o.y = pk2(a.z, a.w); o.z = pk2(b.x, b.y); o.w = pk2(b.z, b.w);
    ((uint4*)dst)[i] = o;
  }
}
DEVINL void transpose_tile(const float* __restrict__ W, int N, u16* __restrict__ WT, int tile, float* tl) {
  const int tid = get_tid();
  int ntn = N >> 6;
  int kt = tile / ntn, nt = tile - kt * ntn;
  int k0 = kt * 64, n0 = nt * 64;
#pragma unroll
  for (int i = 0; i < 2; i++) {
    int r = (tid >> 4) + 32 * i, c4 = (tid & 15) * 4;
    float4 v = *(const float4*)(W + (size_t)(k0 + r) * N + n0 + c4);
    tl[(c4 + 0) * 65 + r] = v.x; tl[(c4 + 1) * 65 + r] = v.y; tl[(c4 + 2) * 65 + r] = v.z; tl[(c4 + 3) * 65 + r] = v.w;
  }
  __syncthreads();
  {
    int n = tid >> 3, k8 = (tid & 7) * 8;
    float x[8];
#pragma unroll
    for (int j = 0; j < 8; j++) x[j] = tl[n * 65 + k8 + j];
    *(uint4*)(WT + (size_t)(n0 + n) * 1024 + k0 + k8) = pack8(x);
  }
  __syncthreads();
}
DEVINL void quant_rows(const Params& p, int r0, int r1, int hb, int nh) {
  const int tid_ = get_tid(); const int lane = tid_ & 63, wid = __builtin_amdgcn_readfirstlane(tid_ >> 6);
  for (int rr = r0 + hb * 8 + wid; rr < r1; rr += nh * 8) {
    const bool isv = rr >= 16384;
    const int row = isv ? rr - 16384 : rr;
    const float* src = isv ? p.peer_v : p.peer_u;
    unsigned char* dst = isv ? p.Vb8 : p.Ub8;
    float* inv_scale = isv ? p.Vsc : p.Usc;
    const float* rp = src + (size_t)row * 1024 + lane * 16;
    float4 a = *(const float4*)rp, b = *(const float4*)(rp + 4), c = *(const float4*)(rp + 8), d = *(const float4*)(rp + 12);
    float m = fmaxf(fmaxf(fmaxf(fabsf(a.x), fabsf(a.y)), fmaxf(fabsf(a.z), fabsf(a.w))), fmaxf(fmaxf(fabsf(b.x), fabsf(b.y)), fmaxf(fabsf(b.z), fabsf(b.w))));
    m = fmaxf(m, fmaxf(fmaxf(fmaxf(fabsf(c.x), fabsf(c.y)), fmaxf(fabsf(c.z), fabsf(c.w))), fmaxf(fmaxf(fabsf(d.x), fabsf(d.y)), fmaxf(fabsf(d.z), fabsf(d.w)))));
#pragma unroll
    for (int o = 32; o >= 1; o >>= 1) m = fmaxf(m, __shfl_xor(m, o));
    if (isv) {
      const float sc = m > 0.f ? 224.0f / m : 1.0f;
      uint4 q;
      int w0 = 0, w1 = 0, w2 = 0, w3 = 0;
      w0 = __builtin_amdgcn_cvt_pk_fp8_f32(a.x * sc, a.y * sc, w0, false); w0 = __builtin_amdgcn_cvt_pk_fp8_f32(a.z * sc, a.w * sc, w0, true);
      w1 = __builtin_amdgcn_cvt_pk_fp8_f32(b.x * sc, b.y * sc, w1, false); w1 = __builtin_amdgcn_cvt_pk_fp8_f32(b.z * sc, b.w * sc, w1, true);
      w2 = __builtin_amdgcn_cvt_pk_fp8_f32(c.x * sc, c.y * sc, w2, false); w2 = __builtin_amdgcn_cvt_pk_fp8_f32(c.z * sc, c.w * sc, w2, true);
      w3 = __builtin_amdgcn_cvt_pk_fp8_f32(d.x * sc, d.y * sc, w3, false); w3 = __builtin_amdgcn_cvt_pk_fp8_f32(d.z * sc, d.w * sc, w3, true);
      q.x = (unsigned)w0; q.y = (unsigned)w1; q.z = (unsigned)w2; q.w = (unsigned)w3;
      *(uint4*)(dst + (size_t)row * 1024 + lane * 16) = q;
      if (lane == 0) inv_scale[row] = m > 0.f ? m / 224.0f : 1.0f;
    }
    {
      const float xv[16] = {a.x, a.y, a.z, a.w, b.x, b.y, b.z, b.w, c.x, c.y, c.z, c.w, d.x, d.y, d.z, d.w};
      float ss = 0.f;
#pragma unroll
      for (int i = 0; i < 16; i++) ss += xv[i] * xv[i];
      ss = wave_sum(ss);
      float clipv = 2.6f * sqrtf(ss * (1.0f / 1024.0f));
      clipv = fminf(clipv, m);
      const float sc = clipv > 0.f ? 7.0f / clipv : 1.0f;
      unsigned w0 = 0u, w1 = 0u;
#pragma unroll
      for (int i = 0; i < 8; i++) {
        int q0 = (int)rintf(xv[i] * sc), q1 = (int)rintf(xv[i + 8] * sc);
        q0 = q0 < -7 ? -7 : (q0 > 7 ? 7 : q0); q1 = q1 < -7 ? -7 : (q1 > 7 ? 7 : q1);
        w0 |= (isv ? (unsigned)(q0 + 8) : ((unsigned)q0 & 15u)) << (4 * i);
        w1 |= (isv ? (unsigned)(q1 + 8) : ((unsigned)q1 & 15u)) << (4 * i);
      }
      *(uint2*)((isv ? p.Vb4 : p.Ub4) + (size_t)row * 512 + lane * 8) = make_uint2(w0, w1);
      if (lane == 0) (isv ? p.Vsc4 : p.Usc)[row] = clipv > 0.f ? clipv / 7.0f : 1.0f;
    }
  }
}
DEVINL void prep_phase(const Params& p, char* smem) {
  float* tl = (float*)smem;
  for (int t = blockIdx.x; t < 2560; t += gridDim.x) {
    if (t < 768) transpose_tile(p.w_in, 3072, p.WinT, t, tl);
    else if (t < 1024) transpose_tile(p.w_o, 1024, p.WoT, t - 768, tl);
    else if (t < 1280) transpose_tile(p.ca_wq, 1024, p.WqT, t - 1024, tl);
    else if (t < 1536) transpose_tile(p.ca_wk, 1024, p.WkvT, t - 1280, tl);
    else if (t < 1792) transpose_tile(p.ca_wv, 1024, p.WkvT + (size_t)1024 * 1024, t - 1536, tl);
    else if (t < 2048) transpose_tile(p.ca_wo, 1024, p.WcoT, t - 1792, tl);
    else transpose_tile(p.peer_wq, 2048, p.PwqT, t - 2048, tl);
  }
  cvt_range(p.x_prompt, p.Xb, (size_t)T_P * 1024 / 8);
  cvt_range(p.x_sample, p.Xb + (size_t)T_P * 1024, (size_t)1024 * 1024 / 8);
  cvt_range(p.mem_prompt, p.Memb, (size_t)2048 * 1024 / 8);
  cvt_range(p.peer_subkeys, p.SubK, (size_t)262144 / 8);
  for (int i = blockIdx.x * NT + get_tid(); i < 2056 * 64; i += gridDim.x * NT) {
    int pr = i >> 6, j = i & 63;
    int pos = pr < 2048 ? pr : 16384 + (pr - 2048);
    float inv = (float)exp(-((double)j / 64.0) * 9.210340371976184);
    float ang = (float)pos * inv;
    double a = (double)ang;
    double k = rint(a * 0.15915494309189535);
    double r = fma(-k, 6.283185307179586, a);
    r = fma(-k, 2.4492935982947064e-16, r);
    float rf = (float)r;
    float s, c;
    sincosf(rf, &s, &c);
    p.rope_cos[i] = c;
    p.rope_sin[i] = s;
  }
}

typedef unsigned int u32x4 __attribute__((ext_vector_type(4)));
struct Stg { u32x4 a0, a1, b0, b1, b2, b3; };
template <int BCH>
DEVINL void g_load(Stg& s, const u16* Ap, const u16* Bp, int kt) {
  s.a0 = *(const u32x4*)(Ap + kt * 64);
  s.a1 = *(const u32x4*)(Ap + (size_t)64 * 1024 + kt * 64);
  s.b0 = *(const u32x4*)(Bp + kt * 64);
  s.b1 = *(const u32x4*)(Bp + (size_t)64 * 1024 + kt * 64);
  if (BCH == 4) {
    s.b2 = *(const u32x4*)(Bp + (size_t)128 * 1024 + kt * 64);
    s.b3 = *(const u32x4*)(Bp + (size_t)192 * 1024 + kt * 64);
  }
}
template <int BCH>
DEVINL void s_store(const Stg& s, char* da, int lr, int lc) {
  *(u32x4*)(da + sw128(lr, lc)) = s.a0;
  *(u32x4*)(da + sw128(lr + 64, lc)) = s.a1;
  char* db = da + 128 * 128;
  *(u32x4*)(db + sw128(lr, lc)) = s.b0;
  *(u32x4*)(db + sw128(lr + 64, lc)) = s.b1;
  if (BCH == 4) {
    *(u32x4*)(db + sw128(lr + 128, lc)) = s.b2;
    *(u32x4*)(db + sw128(lr + 192, lc)) = s.b3;
  }
}
template <int BN, int NTW>
DEVINL void g_compute(f32x4 (&acc)[4][NTW], const char* sa, int wm, int wn, int l15, int g4) {
  const char* sb = sa + 128 * 128;
#pragma unroll
  for (int ks = 0; ks < 2; ks++) {
    bf16x8 af[4], bfr[NTW];
    const int c = ks * 4 + g4;
#pragma unroll
    for (int mi = 0; mi < 4; mi++) af[mi] = lds_frag(sa + sw128(wm * 64 + mi * 16 + l15, c));
#pragma unroll
    for (int ni = 0; ni < NTW; ni++) bfr[ni] = lds_frag(sb + sw128(wn * (BN / 4) + ni * 16 + l15, c));
#pragma unroll
    for (int mi = 0; mi < 4; mi++)
#pragma unroll
      for (int ni = 0; ni < NTW; ni++) acc[mi][ni] = mfma16(bfr[ni], af[mi], acc[mi][ni]);
  }
}
template <int BN, class Epi>
DEVINL void gemm_tile(const u16* __restrict__ A, const u16* __restrict__ Bt, int m0, int n0, char* smem, Epi epi) {
  constexpr int K = 1024, NKT = 16;
  constexpr int NTW = BN / 64;
  constexpr int STAGE = 128 * 128 + BN * 128;
  constexpr int BCH = BN * 8 / NT;
  const int tid = get_tid(), lane = tid & 63, wid = tid >> 6, wm = wid >> 2, wn = wid & 3;
  const int l15 = lane & 15, g4 = lane >> 4;
  f32x4 acc[4][NTW];
#pragma unroll
  for (int i = 0; i < 4; i++)
#pragma unroll
    for (int j = 0; j < NTW; j++) acc[i][j] = (f32x4){0.f, 0.f, 0.f, 0.f};
  Stg s0, s1;
  const int lr = tid >> 3, lc = tid & 7;
  const u16* Ap = A + (size_t)(m0 + lr) * K + lc * 8;
  const u16* Bp = Bt + (size_t)(n0 + lr) * K + lc * 8;
  g_load<BCH>(s0, Ap, Bp, 0);
  s_store<BCH>(s0, smem, lr, lc);
  g_load<BCH>(s1, Ap, Bp, 1);
  g_load<BCH>(s0, Ap, Bp, 2);
  __syncthreads();
#pragma unroll 4
  for (int kt = 0; kt < NKT; kt += 2) {
    s_store<BCH>(s1, smem + STAGE, lr, lc);
    if (kt + 3 < NKT) g_load<BCH>(s1, Ap, Bp, kt + 3);
    g_compute<BN, NTW>(acc, smem, wm, wn, l15, g4);
    __syncthreads();
    if (kt + 2 < NKT) s_store<BCH>(s0, smem, lr, lc);
    if (kt + 4 < NKT) g_load<BCH>(s0, Ap, Bp, kt + 4);
    g_compute<BN, NTW>(acc, smem + STAGE, wm, wn, l15, g4);
    __syncthreads();
  }
#pragma unroll
  for (int mi = 0; mi < 4; mi++)
#pragma unroll
    for (int ni = 0; ni < NTW; ni++) {
      int m = m0 + wm * 64 + mi * 16 + l15;
      int n = n0 + wn * (BN / 4) + ni * 16 + g4 * 4;
      epi(m, n, acc[mi][ni]);
    }
}

template <int BN, class Coord, class Epi>
DEVINL void gemm_run(const u16* __restrict__ A, const u16* __restrict__ Bt, int t0, int t1, int tstep, Coord coord, char* smem, Epi epi) {
  if (t0 >= t1) return;
  constexpr int K = 1024, NKT = 16;
  constexpr int NTW = BN / 64;
  constexpr int STAGE = 128 * 128 + BN * 128;
  constexpr int BCH = BN * 8 / NT;
  const int tid = get_tid(), lane = tid & 63, wid = tid >> 6, wm = wid >> 2, wn = wid & 3;
  const int l15 = lane & 15, g4 = lane >> 4;
  const int lr = tid >> 3, lc = tid & 7;
  int m0, n0;
  coord(t0, m0, n0);
  const u16* Ap = A + (size_t)(m0 + lr) * K + lc * 8;
  const u16* Bp = Bt + (size_t)(n0 + lr) * K + lc * 8;
  Stg s0, s1;
  g_load<BCH>(s0, Ap, Bp, 0);
  g_load<BCH>(s1, Ap, Bp, 1);
  for (int t = t0; t < t1; t += tstep) {
    f32x4 acc[4][NTW];
#pragma unroll
    for (int i = 0; i < 4; i++)
#pragma unroll
      for (int j = 0; j < NTW; j++) acc[i][j] = (f32x4){0.f, 0.f, 0.f, 0.f};
    s_store<BCH>(s0, smem, lr, lc);
    g_load<BCH>(s0, Ap, Bp, 2);
    __syncthreads();
#pragma unroll 4
    for (int kt = 0; kt < NKT; kt += 2) {
      s_store<BCH>(s1, smem + STAGE, lr, lc);
      if (kt + 3 < NKT) g_load<BCH>(s1, Ap, Bp, kt + 3);
      g_compute<BN, NTW>(acc, smem, wm, wn, l15, g4);
      __syncthreads();
      if (kt + 2 < NKT) s_store<BCH>(s0, smem, lr, lc);
      if (kt + 4 < NKT) g_load<BCH>(s0, Ap, Bp, kt + 4);
      g_compute<BN, NTW>(acc, smem + STAGE, wm, wn, l15, g4);
      __syncthreads();
    }
    const int tn = t + tstep;
    int m0n = m0, n0n = n0;
    if (tn < t1) {
      coord(tn, m0n, n0n);
      Ap = A + (size_t)(m0n + lr) * K + lc * 8;
      Bp = Bt + (size_t)(n0n + lr) * K + lc * 8;
      g_load<BCH>(s0, Ap, Bp, 0);
      g_load<BCH>(s1, Ap, Bp, 1);
    }
#pragma unroll
    for (int mi = 0; mi < 4; mi++)
#pragma unroll
      for (int ni = 0; ni < NTW; ni++) {
        int m = m0 + wm * 64 + mi * 16 + l15;
        int n = n0 + wn * (BN / 4) + ni * 16 + g4 * 4;
        epi(m, n, acc[mi][ni]);
      }
    m0 = m0n; n0 = n0n;
  }
}
DEVINL int first_ge(int bid, int nb, int lo) { return bid >= lo ? bid : bid + ((lo - bid + nb - 1) / nb) * nb; }

DEVINL void ln_phase(const u16* __restrict__ pre, const float* __restrict__ gam, const float* __restrict__ bet,
                     u16* __restrict__ outb) {
  const int tid_ = get_tid(); const int lane = tid_ & 63, wid = __builtin_amdgcn_readfirstlane(tid_ >> 6);
  for (int row = blockIdx.x * 8 + wid; row < T_ALL; row += gridDim.x * 8) {
    float v[16];
    {
      uint4 a = *(const uint4*)(pre + (size_t)row * 1024 + lane * 8);
      uint4 b = *(const uint4*)(pre + (size_t)row * 1024 + 512 + lane * 8);
      unpack8(a, v); unpack8(b, v + 8);
    }
    float s = 0.f;
#pragma unroll
    for (int i = 0; i < 16; i++) s += v[i];
    float mean = wave_sum(s) * (1.0f / 1024.0f);
    float q = 0.f;
#pragma unroll
    for (int i = 0; i < 16; i++) { float d = v[i] - mean; q += d * d; }
    float rstd = rsqrtf(wave_sum(q) * (1.0f / 1024.0f) + LN_EPS_F);
#pragma unroll
    for (int hf = 0; hf < 2; hf++) {
      int col = hf * 512 + lane * 8;
      float4 g0 = *(const float4*)(gam + col), g1 = *(const float4*)(gam + col + 4);
      float4 b0 = *(const float4*)(bet + col), b1 = *(const float4*)(bet + col + 4);
      float y[8];
      const float* o = v + hf * 8;
      y[0] = (o[0] - mean) * rstd * g0.x + b0.x; y[1] = (o[1] - mean) * rstd * g0.y + b0.y;
      y[2] = (o[2] - mean) * rstd * g0.z + b0.z; y[3] = (o[3] - mean) * rstd * g0.w + b0.w;
      y[4] = (o[4] - mean) * rstd * g1.x + b1.x; y[5] = (o[5] - mean) * rstd * g1.y + b1.y;
      y[6] = (o[6] - mean) * rstd * g1.z + b1.z; y[7] = (o[7] - mean) * rstd * g1.w + b1.w;
      *(uint4*)(outb + (size_t)row * 1024 + col) = pack8(y);
    }
  }
}

DEVINL void gate_prompt_item(const Params& p, int id, char* smem) {
  const int tid = get_tid(), lane = tid & 63, wid = tid >> 6, l15 = lane & 15, g4 = lane >> 4;
  const int b = id >> 6, n = (id >> 2) & 15, g = id & 3;
  const int tok0 = b * 2048 + n * 128;
  char* WsL = smem;
  char* VnL = smem + 32768;
  const float* ws = p.w_s + g * 16384;
#pragma unroll
  for (int i = 0; i < 4; i++) {
    int q = tid + i * 512, t = q >> 4, c = q & 15, s0 = c * 8;
    float4 a = *(const float4*)(ws + t * 128 + s0), bb = *(const float4*)(ws + t * 128 + s0 + 4);
    float x[8] = {a.x, a.y, a.z, a.w, bb.x, bb.y, bb.z, bb.w};
#pragma unroll
    for (int j = 0; j < 8; j++) x[j] = (s0 + j <= t) ? x[j] : 0.f;
    *(uint4*)(WsL + sw256(t, c)) = pack8(x);
  }
#pragma unroll
  for (int i = 0; i < 4; i++) {
    int q = tid + i * 512, s = q >> 4, c = q & 15;
    uint4 raw = *(const uint4*)(p.Hb + (size_t)(tok0 + s) * 3072 + 512 + g * 128 + c * 8);
    float x[8]; unpack8(raw, x);
    float sum = 0.f;
#pragma unroll
    for (int j = 0; j < 8; j++) sum += x[j];
    sum += __shfl_xor(sum, 1); sum += __shfl_xor(sum, 2); sum += __shfl_xor(sum, 4); sum += __shfl_xor(sum, 8);
    float mean = sum * (1.0f / 128.0f);
    float var = 0.f;
#pragma unroll
    for (int j = 0; j < 8; j++) { float d = x[j] - mean; var += d * d; }
    var += __shfl_xor(var, 1); var += __shfl_xor(var, 2); var += __shfl_xor(var, 4); var += __shfl_xor(var, 8);
    float rstd = rsqrtf(var * (1.0f / 128.0f) + LN_EPS_F);
    const float* gp = p.gate_ln_g + g * 128 + c * 8;
    const float* bp = p.gate_ln_b + g * 128 + c * 8;
#pragma unroll
    for (int j = 0; j < 8; j++) x[j] = (x[j] - mean) * rstd * gp[j] + bp[j];
    *(uint4*)(VnL + s * 272 + c * 16) = pack8(x);
  }
  __syncthreads();
  f32x4 acc[8];
#pragma unroll
  for (int i = 0; i < 8; i++) acc[i] = (f32x4){0.f, 0.f, 0.f, 0.f};
#pragma unroll
  for (int ks = 0; ks < 4; ks++) {
    bf16x8 af = tr_frag(VnL, 272, 32 * ks, 16 * wid, lane);
#pragma unroll
    for (int ti = 0; ti < 8; ti++) {
      if (32 * ks <= 16 * ti + 15) {
        bf16x8 bw = lds_frag(WsL + sw256(16 * ti + l15, ks * 4 + g4));
        acc[ti] = mfma16(af, bw, acc[ti]);
      }
    }
  }
#pragma unroll
  for (int ti = 0; ti < 8; ti++) {
    int t = 16 * ti + l15, c = 16 * wid + 4 * g4, tok = tok0 + t;
    float bs = p.b_s[g * 128 + t];
    uint2 ua = *(const uint2*)(p.Hb + (size_t)tok * 3072 + g * 128 + c);
    float o0 = bflo(ua.x) * (acc[ti][0] + bs), o1 = bfhi(ua.x) * (acc[ti][1] + bs);
    float o2 = bflo(ua.y) * (acc[ti][2] + bs), o3 = bfhi(ua.y) * (acc[ti][3] + bs);
    uint2 o; o.x = pk2(o0, o1); o.y = pk2(o2, o3);
    *(uint2*)(p.MIXIN + (size_t)tok * 1024 + g * 128 + c) = o;
  }
  __syncthreads();
}

DEVINL void r1_item(const Params& p, int id, char* smem) {
  const int tid = get_tid(), lane = tid & 63, wid = tid >> 6, l15 = lane & 15, g4 = lane >> 4;
  const int b = id >> 6, h = (id >> 4) & 3, n = id & 15;
  const int tok0 = b * 2048 + n * 128;
  char* KL = smem;
  char* VL = smem + 34816;
  const float lg = logf(1.0f - exp2f(-5.0f - (float)h));
#pragma unroll
  for (int i = 0; i < 2; i++) {
    int q = tid + i * 512, j = q >> 3, ch = q & 7;
    int pr = n * 128 + j;
    float cs[8], sn[8];
    {
      float4 c0 = *(const float4*)(p.rope_cos + pr * 64 + ch * 8), c1 = *(const float4*)(p.rope_cos + pr * 64 + ch * 8 + 4);
      float4 s0 = *(const float4*)(p.rope_sin + pr * 64 + ch * 8), s1 = *(const float4*)(p.rope_sin + pr * 64 + ch * 8 + 4);
      cs[0] = c0.x; cs[1] = c0.y; cs[2] = c0.z; cs[3] = c0.w; cs[4] = c1.x; cs[5] = c1.y; cs[6] = c1.z; cs[7] = c1.w;
      sn[0] = s0.x; sn[1] = s0.y; sn[2] = s0.z; sn[3] = s0.w; sn[4] = s1.x; sn[5] = s1.y; sn[6] = s1.z; sn[7] = s1.w;
    }
    u16* rowp = p.Hb + (size_t)(tok0 + j) * 3072;
    {
      u16* qp = rowp + 1024 + h * 128 + ch * 8;
      uint4 a = *(const uint4*)qp, bb = *(const uint4*)(qp + 64);
      float x1[8], x2[8], o1[8], o2[8];
      unpack8(a, x1); unpack8(bb, x2);
#pragma unroll
      for (int e = 0; e < 8; e++) { o1[e] = x1[e] * cs[e] - x2[e] * sn[e]; o2[e] = x1[e] * sn[e] + x2[e] * cs[e]; }
      u16* qo = p.QKR + (size_t)(tok0 + j) * 1024 + h * 128 + ch * 8;
      *(uint4*)qo = pack8(o1);
      *(uint4*)(qo + 64) = pack8(o2);
    }
    {
      u16* kp = rowp + 1536 + h * 128 + ch * 8;
      uint4 a = *(const uint4*)kp, bb = *(const uint4*)(kp + 64);
      float x1[8], x2[8], o1[8], o2[8];
      unpack8(a, x1); unpack8(bb, x2);
      const float sc = 0.08838834764831845f;
#pragma unroll
      for (int e = 0; e < 8; e++) { o1[e] = (x1[e] * cs[e] - x2[e] * sn[e]) * sc; o2[e] = (x1[e] * sn[e] + x2[e] * cs[e]) * sc; }
      u16* ko = p.QKR + (size_t)(tok0 + j) * 1024 + 512 + h * 128 + ch * 8;
      *(uint4*)ko = pack8(o1);
      *(uint4*)(ko + 64) = pack8(o2);
      float dec = __expf(lg * (float)(127 - j));
#pragma unroll
      for (int e = 0; e < 8; e++) { o1[e] *= dec; o2[e] *= dec; }
      *(uint4*)(KL + j * 272 + ch * 16) = pack8(o1);
      *(uint4*)(KL + j * 272 + (ch + 8) * 16) = pack8(o2);
    }
  }
#pragma unroll
  for (int i = 0; i < 4; i++) {
    int q = tid + i * 512, j = q >> 4, c = q & 15;
    *(uint4*)(VL + j * 272 + c * 16) = *(const uint4*)(p.Hb + (size_t)(tok0 + j) * 3072 + 2048 + h * 128 + c * 8);
  }
  __syncthreads();
  f32x4 acc[8];
#pragma unroll
  for (int i = 0; i < 8; i++) acc[i] = (f32x4){0.f, 0.f, 0.f, 0.f};
#pragma unroll
  for (int ks = 0; ks < 4; ks++) {
    bf16x8 af = tr_frag(VL, 272, 32 * ks, 16 * wid, lane);
#pragma unroll
    for (int dt = 0; dt < 8; dt++) {
      bf16x8 bk = tr_frag(KL, 272, 32 * ks, 16 * dt, lane);
      acc[dt] = mfma16(af, bk, acc[dt]);
    }
  }
  float* U = p.U + (size_t)id * 16384;
#pragma unroll
  for (int dt = 0; dt < 8; dt++)
#pragma unroll
    for (int r = 0; r < 4; r++) U[(16 * wid + 4 * g4 + r) * 128 + 16 * dt + l15] = acc[dt][r];
  __syncthreads();
}

DEVINL void ret_sample_item(const Params& p, int id, char* smem) {
  const int tid = get_tid(), lane = tid & 63, wid = tid >> 6;
  const int b = id >> 2, h = id & 3;
  float* qf = (float*)smem;
  float* kf = qf + 1024;
  float* kd = kf + 1024;
  float* vf = kd + 1024;
  float* PL = vf + 1024;
  float* red = PL + 64;
  const float lg = logf(1.0f - exp2f(-5.0f - (float)h));
  {
    int i = tid >> 6, dp = tid & 63;
    int tok = T_P + b * 8 + i, pr = 2048 + i;
    float c = p.rope_cos[pr * 64 + dp], s = p.rope_sin[pr * 64 + dp];
    const u16* rowp = p.Hb + (size_t)tok * 3072;
    float q1 = bf1(rowp[1024 + h * 128 + dp]), q2 = bf1(rowp[1024 + h * 128 + 64 + dp]);
    qf[i * 128 + dp] = q1 * c - q2 * s;
    qf[i * 128 + 64 + dp] = q1 * s + q2 * c;
    const float sc = 0.08838834764831845f;
    float k1 = bf1(rowp[1536 + h * 128 + dp]), k2 = bf1(rowp[1536 + h * 128 + 64 + dp]);
    float ka = (k1 * c - k2 * s) * sc, kb = (k1 * s + k2 * c) * sc;
    kf[i * 128 + dp] = ka; kf[i * 128 + 64 + dp] = kb;
    float dec = __expf(lg * (float)(7 - i));
    kd[i * 128 + dp] = ka * dec; kd[i * 128 + 64 + dp] = kb * dec;
    vf[i * 128 + dp] = bf1(rowp[2048 + h * 128 + dp]);
    vf[i * 128 + 64 + dp] = bf1(rowp[2048 + h * 128 + 64 + dp]);
  }
  __syncthreads();
  if (tid < 64) {
    int i = tid >> 3, j = tid & 7;
    float s = 0.f;
    if (j <= i) {
      for (int d = 0; d < 128; d++) s += qf[i * 128 + d] * kf[j * 128 + d];
      s *= __expf(lg * (float)(i - j));
    }
    PL[tid] = s;
  }
  {
    int e = tid & 127, dq = tid >> 7;
    const float* S0 = p.state_ret + (size_t)(b * 4 + h) * 16384;
    float* Sn = p.new_ret_sample + (size_t)(b * 4 + h) * 16384;
    float part[8], vv[8];
#pragma unroll
    for (int i = 0; i < 8; i++) { part[i] = 0.f; vv[i] = vf[i * 128 + e]; }
    const float c8 = __expf(lg * 8.0f);
    float s0v[32];
#pragma unroll
    for (int dd = 0; dd < 32; dd++) s0v[dd] = S0[(dq * 32 + dd) * 128 + e];
#pragma unroll
    for (int dd = 0; dd < 32; dd++) {
      const int d = dq * 32 + dd;
      float s = s0v[dd];
      float sn = s * c8;
#pragma unroll
      for (int j = 0; j < 8; j++) sn += kd[j * 128 + d] * vv[j];
      Sn[d * 128 + e] = sn;
#pragma unroll
      for (int i = 0; i < 8; i++) part[i] += qf[i * 128 + d] * s;
    }
#pragma unroll
    for (int i = 0; i < 8; i++) red[(dq * 8 + i) * 128 + e] = part[i];
  }
  __syncthreads();
  {
    int i = wid;
    int tok = T_P + b * 8 + i;
    float qdec = __expf(lg * (float)(i + 1));
    float o[2];
#pragma unroll
    for (int hf = 0; hf < 2; hf++) {
      int e = lane + 64 * hf;
      float a = 0.f;
#pragma unroll
      for (int j = 0; j < 8; j++) a += PL[i * 8 + j] * vf[j * 128 + e];
      float r = red[(0 * 8 + i) * 128 + e] + red[(1 * 8 + i) * 128 + e] + red[(2 * 8 + i) * 128 + e] + red[(3 * 8 + i) * 128 + e];
      o[hf] = a + qdec * r;
    }
    float mean = wave_sum(o[0] + o[1]) * (1.0f / 128.0f);
    float d0 = o[0] - mean, d1 = o[1] - mean;
    float rstd = rsqrtf(wave_sum(d0 * d0 + d1 * d1) * (1.0f / 128.0f) + LN_EPS_F);
#pragma unroll
    for (int hf = 0; hf < 2; hf++) {
      int e = lane + 64 * hf;
      float on = (o[hf] - mean) * rstd * p.ret_gn_g[h * 128 + e] + p.ret_gn_b[h * 128 + e];
      float sg = bf1(p.Hb[(size_t)tok * 3072 + 2560 + h * 128 + e]);
      p.MIXIN[(size_t)tok * 1024 + 512 + h * 128 + e] = f2bf(sg * on);
    }
  }
  __syncthreads();
}

DEVINL void gate_sample_item(const Params& p, int b, char* smem) {
  const int tid = get_tid(), lane = tid & 63, wid = tid >> 6;
  float* VS = (float*)smem;
  {
    int s = wid, tok = T_P + b * 8 + s;
    uint4 raw = *(const uint4*)(p.Hb + (size_t)tok * 3072 + 512 + lane * 8);
    float x[8]; unpack8(raw, x);
    float sum = 0.f;
#pragma unroll
    for (int j = 0; j < 8; j++) sum += x[j];
    sum += __shfl_xor(sum, 1); sum += __shfl_xor(sum, 2); sum += __shfl_xor(sum, 4); sum += __shfl_xor(sum, 8);
    float mean = sum * (1.0f / 128.0f);
    float var = 0.f;
#pragma unroll
    for (int j = 0; j < 8; j++) { float d = x[j] - mean; var += d * d; }
    var += __shfl_xor(var, 1); var += __shfl_xor(var, 2); var += __shfl_xor(var, 4); var += __shfl_xor(var, 8);
    float rstd = rsqrtf(var * (1.0f / 128.0f) + LN_EPS_F);
#pragma unroll
    for (int j = 0; j < 8; j++) x[j] = (x[j] - mean) * rstd * p.gate_ln_g[lane * 8 + j] + p.gate_ln_b[lane * 8 + j];
    float* go = p.new_gate_v + (size_t)(b * 8 + s) * 512 + lane * 8;
    *(float4*)go = make_float4(x[0], x[1], x[2], x[3]);
    *(float4*)(go + 4) = make_float4(x[4], x[5], x[6], x[7]);
#pragma unroll
    for (int j = 0; j < 8; j++) VS[s * 512 + lane * 8 + j] = x[j];
  }
  __syncthreads();
  {
    int g = tid >> 7;
    float vs[8];
#pragma unroll
    for (int s = 0; s < 8; s++) vs[s] = VS[s * 512 + tid];
#pragma unroll
    for (int t = 0; t < 8; t++) {
      float mixed = p.b_s[g * 128 + t];
#pragma unroll
      for (int s = 0; s < 8; s++)
        if (s <= t) mixed += p.w_s[g * 16384 + t * 128 + s] * vs[s];
      int tok = T_P + b * 8 + t;
      float ua = bf1(p.Hb[(size_t)tok * 3072 + tid]);
      p.MIXIN[(size_t)tok * 1024 + tid] = f2bf(ua * mixed);
    }
  }
  __syncthreads();
}

DEVINL void ret_scan_item(const Params& p, int id) {
  const int tid = get_tid();
  const int bh = id >> 3, q = (id & 7) * 512 + tid, h = bh & 3;
  const float lg = logf(1.0f - exp2f(-5.0f - (float)h));
  const float c128 = __expf(lg * 128.0f);
  const float4* ub = (const float4*)(p.U + (size_t)(bh * 16) * 16384) + q;
  float4 u[16];
#pragma unroll
  for (int n = 0; n < 16; n++) u[n] = ub[(size_t)n * 4096];
  float4 sv = make_float4(0.f, 0.f, 0.f, 0.f);
  uint2* sp = (uint2*)(p.SP + (size_t)(bh * 16) * 16384) + q;
#pragma unroll
  for (int n = 0; n < 16; n++) {
    uint2 o; o.x = pk2(sv.x, sv.y); o.y = pk2(sv.z, sv.w);
    sp[(size_t)n * 4096] = o;
    sv.x = sv.x * c128 + u[n].x; sv.y = sv.y * c128 + u[n].y; sv.z = sv.z * c128 + u[n].z; sv.w = sv.w * c128 + u[n].w;
  }
  const int e = q >> 5, d4 = (q & 31) * 4;
  float* outp = p.new_ret_prompt + (size_t)bh * 16384;
  outp[(d4 + 0) * 128 + e] = sv.x;
  outp[(d4 + 1) * 128 + e] = sv.y;
  outp[(d4 + 2) * 128 + e] = sv.z;
  outp[(d4 + 3) * 128 + e] = sv.w;
}

DEVINL void r3_item(const Params& p, int id, char* smem) {
  const int tid = get_tid(), lane = tid & 63, wid = tid >> 6, l15 = lane & 15, g4 = lane >> 4;
  const int n = id < 256 ? 15 - (id >> 5) : ((id - 256) >> 5), bh = id & 31, b = bh >> 2, h = bh & 3;
  const int tok0 = b * 2048 + n * 128;
  char* KL = smem;
  char* VL = smem + 32768;
  char* STL = smem + 32768 + 34816;
  const float lg = logf(1.0f - exp2f(-5.0f - (float)h));
  const float c128 = __expf(lg * 128.0f);
#pragma unroll
  for (int i = 0; i < 4; i++) {
    int q = tid + i * 512, j = q >> 4, c = q & 15;
    const u16* rowp = p.Hb + (size_t)(tok0 + j) * 3072;
    *(uint4*)(KL + sw256(j, c)) = *(const uint4*)(p.QKR + (size_t)(tok0 + j) * 1024 + 512 + h * 128 + c * 8);
    *(uint4*)(VL + j * 272 + c * 16) = *(const uint4*)(rowp + 2048 + h * 128 + c * 8);
  }
  {
    const u16* spb = p.SP + (size_t)(bh * 16 + n) * 16384;
#pragma unroll
    for (int i = 0; i < 4; i++) {
      int q = tid + i * 512, e = q >> 4, c = q & 15;
      *(uint4*)(STL + sw256(e, c)) = *(const uint4*)(spb + e * 128 + c * 8);
    }
  }
  const int irow = 16 * wid + l15;
  const u16* qrow = p.Hb + (size_t)(tok0 + irow) * 3072;
  bf16x8 qf[4], qd[4];
  {
    const float qdec = __expf(lg * (float)(irow + 1));
#pragma unroll
    for (int ks = 0; ks < 4; ks++) {
      uint4 raw = *(const uint4*)(p.QKR + (size_t)(tok0 + irow) * 1024 + h * 128 + ks * 32 + 8 * g4);
      qf[ks] = as_frag(raw);
      float x[8]; unpack8(raw, x);
#pragma unroll
      for (int j = 0; j < 8; j++) x[j] *= qdec;
      qd[ks] = as_frag(pack8(x));
    }
  }
  __syncthreads();
  f32x4 pacc[8];
#pragma unroll
  for (int i = 0; i < 8; i++) pacc[i] = (f32x4){0.f, 0.f, 0.f, 0.f};
#pragma unroll
  for (int ks = 0; ks < 4; ks++) {
#pragma unroll
    for (int jt = 0; jt < 8; jt++) {
      if (jt <= wid) {
        bf16x8 kfr = lds_frag(KL + sw256(16 * jt + l15, ks * 4 + g4));
        pacc[jt] = mfma16(kfr, qf[ks], pacc[jt]);
      }
    }
  }
#pragma unroll
  for (int jt = 0; jt < 8; jt++)
#pragma unroll
    for (int r = 0; r < 4; r++) {
      int j = 16 * jt + 4 * g4 + r;
      float v = pacc[jt][r] * __expf(lg * (float)(irow - j));
      pacc[jt][r] = (j <= irow) ? v : 0.f;
    }
  bf16x8 pf[4];
#pragma unroll
  for (int s = 0; s < 4; s++) pf[s] = pack_frag(pacc[2 * s], pacc[2 * s + 1]);
  f32x4 oacc[8];
#pragma unroll
  for (int i = 0; i < 8; i++) oacc[i] = (f32x4){0.f, 0.f, 0.f, 0.f};
#pragma unroll
  for (int s = 0; s < 4; s++) {
    if (2 * s <= wid) {
#pragma unroll
      for (int et = 0; et < 8; et++) {
        bf16x8 vfr = tr_frag_perm(VL, 272, 32 * s, 16 * et, lane);
        oacc[et] = mfma16(vfr, pf[s], oacc[et]);
      }
    }
  }
#pragma unroll
  for (int ks = 0; ks < 4; ks++) {
#pragma unroll
    for (int et = 0; et < 8; et++) {
      bf16x8 sfr = lds_frag(STL + sw256(16 * et + l15, ks * 4 + g4));
      oacc[et] = mfma16(sfr, qd[ks], oacc[et]);
    }
  }
  float sum = 0.f;
#pragma unroll
  for (int et = 0; et < 8; et++) sum += oacc[et][0] + oacc[et][1] + oacc[et][2] + oacc[et][3];
  sum += __shfl_xor(sum, 16); sum += __shfl_xor(sum, 32);
  const float mean = sum * (1.0f / 128.0f);
  float var = 0.f;
#pragma unroll
  for (int et = 0; et < 8; et++)
#pragma unroll
    for (int r = 0; r < 4; r++) { float d = oacc[et][r] - mean; var += d * d; }
  var += __shfl_xor(var, 16); var += __shfl_xor(var, 32);
  const float rstd = rsqrtf(var * (1.0f / 128.0f) + LN_EPS_F);
#pragma unroll
  for (int et = 0; et < 8; et++) {
    int e = 16 * et + 4 * g4;
    float4 gg = *(const float4*)(p.ret_gn_g + h * 128 + e), gb = *(const float4*)(p.ret_gn_b + h * 128 + e);
    uint2 sg = *(const uint2*)(qrow + 2560 + h * 128 + e);
    float o0 = ((oacc[et][0] - mean) * rstd * gg.x + gb.x) * bflo(sg.x);
    float o1 = ((oacc[et][1] - mean) * rstd * gg.y + gb.y) * bfhi(sg.x);
    float o2 = ((oacc[et][2] - mean) * rstd * gg.z + gb.z) * bflo(sg.y);
    float o3 = ((oacc[et][3] - mean) * rstd * gg.w + gb.w) * bfhi(sg.y);
    uint2 o; o.x = pk2(o0, o1); o.y = pk2(o2, o3);
    *(uint2*)(p.MIXIN + (size_t)(tok0 + irow) * 1024 + 512 + h * 128 + e) = o;
  }
  __syncthreads();
}

DEVINL void attn_item(const Params& p, int id, char* smem) {
  const int tid = get_tid(), lane = tid & 63, wid = tid >> 6, l15 = lane & 15, g4 = lane >> 4;
  const bool sample = id >= 512;
  int b, h, tokbase, nvalid;
  if (!sample) { b = id >> 6; h = (id >> 4) & 3; tokbase = b * 2048 + (id & 15) * 128; nvalid = 128; }
  else { int s = id - 512; b = s >> 2; h = s & 3; tokbase = T_P + b * 8; nvalid = 8; }
  if (!sample) {
#pragma unroll 4
    for (int i = 0; i < 16; i++) {
      int q = tid + i * 512, r = q >> 5, c = q & 31;
      *(uint4*)(smem + sw512(r, c)) = *(const uint4*)(p.MemKVb + (size_t)(b * 256 + r) * 2048 + h * 256 + c * 8);
    }
  } else {
#pragma unroll 4
    for (int i = 0; i < 16; i++) {
      int q = tid + i * 512, r = q >> 5, c = q & 31;
      const float* src = p.cache_k + ((size_t)(b * 256 + r) * 4 + h) * 256 + c * 8;
      float4 a = *(const float4*)src, bb = *(const float4*)(src + 4);
      uint4 o; o.x = pk2(a.x, a.y); o.y = pk2(a.z, a.w); o.z = pk2(bb.x, bb.y); o.w = pk2(bb.z, bb.w);
      *(uint4*)(smem + sw512(r, c)) = o;
    }
  }
  __syncthreads();
  const bool active = wid * 16 < nvalid;
  const int irow = wid * 16 + l15;
  const int irc = irow < nvalid ? irow : nvalid - 1;
  const size_t tok = (size_t)(tokbase + irc);
  bf16x8 pf[8];
  float inv_sum = 0.f;
  if (active) {
    const u16* qp = p.QC + tok * 1024 + h * 256 + 8 * g4;
    f32x4 sacc[16];
#pragma unroll
    for (int i = 0; i < 16; i++) sacc[i] = (f32x4){0.f, 0.f, 0.f, 0.f};
    uint4 qcur = *(const uint4*)qp;
#pragma unroll 1
    for (int ks = 0; ks < 8; ks++) {
      uint4 qnext = *(const uint4*)(qp + (ks < 7 ? (ks + 1) * 32 : 0));
      bf16x8 qfr = as_frag(qcur);
#pragma unroll
      for (int mt = 0; mt < 16; mt++) {
        bf16x8 kfr = lds_frag(smem + sw512(16 * mt + l15, ks * 4 + g4));
        sacc[mt] = mfma16(kfr, qfr, sacc[mt]);
      }
      qcur = qnext;
    }
    float mx = -3.0e38f;
#pragma unroll
    for (int mt = 0; mt < 16; mt++)
#pragma unroll
      for (int r = 0; r < 4; r++) mx = fmaxf(mx, sacc[mt][r]);
    mx = fmaxf(mx, __shfl_xor(mx, 16)); mx = fmaxf(mx, __shfl_xor(mx, 32));
    float sum = 0.f;
#pragma unroll
    for (int mt = 0; mt < 16; mt++)
#pragma unroll
      for (int r = 0; r < 4; r++) { float e = __expf(sacc[mt][r] - mx); sacc[mt][r] = e; sum += e; }
    sum += __shfl_xor(sum, 16); sum += __shfl_xor(sum, 32);
    inv_sum = 1.0f / sum;
#pragma unroll
    for (int s = 0; s < 8; s++) pf[s] = pack_frag(sacc[2 * s], sacc[2 * s + 1]);
  }
  __syncthreads();
  if (!sample) {
#pragma unroll 4
    for (int i = 0; i < 16; i++) {
      int q = tid + i * 512, r = q >> 5, c = q & 31;
      *(uint4*)(smem + r * 528 + c * 16) = *(const uint4*)(p.MemKVb + (size_t)(b * 256 + r) * 2048 + 1024 + h * 256 + c * 8);
    }
  } else {
#pragma unroll 4
    for (int i = 0; i < 16; i++) {
      int q = tid + i * 512, r = q >> 5, c = q & 31;
      const float* src = p.cache_v + ((size_t)(b * 256 + r) * 4 + h) * 256 + c * 8;
      float4 a = *(const float4*)src, bb = *(const float4*)(src + 4);
      uint4 o; o.x = pk2(a.x, a.y); o.y = pk2(a.z, a.w); o.z = pk2(bb.x, bb.y); o.w = pk2(bb.z, bb.w);
      *(uint4*)(smem + r * 528 + c * 16) = o;
    }
  }
  __syncthreads();
  if (active) {
    f32x4 oacc[16];
#pragma unroll
    for (int i = 0; i < 16; i++) oacc[i] = (f32x4){0.f, 0.f, 0.f, 0.f};
#pragma unroll
    for (int s = 0; s < 8; s++) {
#pragma unroll
      for (int dt = 0; dt < 16; dt++) {
        bf16x8 vfr = tr_frag_perm(smem, 528, 32 * s, 16 * dt, lane);
        oacc[dt] = mfma16(vfr, pf[s], oacc[dt]);
      }
    }
    if (irow < nvalid) {
#pragma unroll
      for (int dt = 0; dt < 16; dt++) {
        int d = 16 * dt + 4 * g4;
        uint2 o; o.x = pk2(oacc[dt][0] * inv_sum, oacc[dt][1] * inv_sum); o.y = pk2(oacc[dt][2] * inv_sum, oacc[dt][3] * inv_sum);
        *(uint2*)(p.CA + tok * 1024 + h * 256 + d) = o;
      }
    }
  }
  __syncthreads();
}

DEVINL void attn_pair_prompt(const Params& p, int b, int h, int qt0, char* smem) {
  const int tid = get_tid(), lane = tid & 63, wid = tid >> 6, l15 = lane & 15, g4 = lane >> 4;
#pragma unroll 4
  for (int i = 0; i < 16; i++) {
    int q = tid + i * 512, r = q >> 5, c = q & 31;
    *(uint4*)(smem + sw512(r, c)) = *(const uint4*)(p.MemKVb + (size_t)(b * 256 + r) * 2048 + h * 256 + c * 8);
  }
  __syncthreads();
  const int irow = wid * 16 + l15;
  bf16x8 pf[2][8];
  float inv_sum[2];
#pragma unroll
  for (int qq = 0; qq < 2; qq++) {
    const size_t tok = (size_t)(b * 2048 + (qt0 + qq) * 128 + irow);
    const u16* qp = p.QC + tok * 1024 + h * 256 + 8 * g4;
    f32x4 sacc[16];
#pragma unroll
    for (int i = 0; i < 16; i++) sacc[i] = (f32x4){0.f, 0.f, 0.f, 0.f};
    uint4 qcur = *(const uint4*)qp;
#pragma unroll 1
    for (int ks = 0; ks < 8; ks++) {
      uint4 qnext = *(const uint4*)(qp + (ks < 7 ? (ks + 1) * 32 : 0));
      bf16x8 qfr = as_frag(qcur);
#pragma unroll
      for (int mt = 0; mt < 16; mt++) {
        bf16x8 kfr = lds_frag(smem + sw512(16 * mt + l15, ks * 4 + g4));
        sacc[mt] = mfma16(kfr, qfr, sacc[mt]);
        if (mt == 7) __builtin_amdgcn_sched_barrier(0);
      }
      qcur = qnext;
    }
    float mx = -3.0e38f;
#pragma unroll
    for (int mt = 0; mt < 16; mt++)
#pragma unroll
      for (int r = 0; r < 4; r++) mx = fmaxf(mx, sacc[mt][r]);
    mx = fmaxf(mx, __shfl_xor(mx, 16)); mx = fmaxf(mx, __shfl_xor(mx, 32));
    float sum = 0.f;
#pragma unroll
    for (int mt = 0; mt < 16; mt++)
#pragma unroll
      for (int r = 0; r < 4; r++) { float e = __expf(sacc[mt][r] - mx); sacc[mt][r] = e; sum += e; }
    sum += __shfl_xor(sum, 16); sum += __shfl_xor(sum, 32);
    inv_sum[qq] = 1.0f / sum;
#pragma unroll
    for (int s = 0; s < 8; s++) pf[qq][s] = pack_frag(sacc[2 * s], sacc[2 * s + 1]);
    __builtin_amdgcn_sched_barrier(0);
  }
  __syncthreads();
#pragma unroll 4
  for (int i = 0; i < 16; i++) {
    int q = tid + i * 512, r = q >> 5, c = q & 31;
    *(uint4*)(smem + r * 528 + c * 16) = *(const uint4*)(p.MemKVb + (size_t)(b * 256 + r) * 2048 + 1024 + h * 256 + c * 8);
  }
  __syncthreads();
#pragma unroll
  for (int qq = 0; qq < 2; qq++) {
    const size_t tok = (size_t)(b * 2048 + (qt0 + qq) * 128 + irow);
    f32x4 oacc[16];
#pragma unroll
    for (int i = 0; i < 16; i++) oacc[i] = (f32x4){0.f, 0.f, 0.f, 0.f};
#pragma unroll
    for (int s = 0; s < 8; s++) {
#pragma unroll
      for (int dt = 0; dt < 16; dt++) {
        bf16x8 vfr = tr_frag_perm(smem, 528, 32 * s, 16 * dt, lane);
        oacc[dt] = mfma16(vfr, pf[qq][s], oacc[dt]);
        if ((dt & 7) == 7) __builtin_amdgcn_sched_barrier(0);
      }
    }
    const float is = inv_sum[qq];
#pragma unroll
    for (int dt = 0; dt < 16; dt++) {
      int d = 16 * dt + 4 * g4;
      uint2 o; o.x = pk2(oacc[dt][0] * is, oacc[dt][1] * is); o.y = pk2(oacc[dt][2] * is, oacc[dt][3] * is);
      *(uint2*)(p.CA + tok * 1024 + h * 256 + d) = o;
    }
    __builtin_amdgcn_sched_barrier(0);
  }
  __syncthreads();
}

DEVINL int mono(float f) { int b = __float_as_int(f); return b ^ ((b >> 31) & 0x7fffffff); }
DEVINL float unmono(int k) { return __int_as_float(k ^ ((k >> 31) & 0x7fffffff)); }
#define INS16(top, xv) { int _x = (xv); _Pragma("unroll") for (int _k = 0; _k < 16; _k++) { int _h = max(top[_k], _x); _x = min(top[_k], _x); top[_k] = _h; } }

struct CandTab { int a[64], b[64]; };
constexpr CandTab make_cand_tab() {
  CandTab t{};
  int sl = 0;
  for (int a = 0; a < 16; a++)
    for (int bb = 0; bb < 16; bb++)
      if ((a + 1) * (bb + 1) <= 16) { t.a[sl] = a; t.b[sl] = bb; sl++; }
  for (; sl < 64; sl++) { t.a[sl] = -1; t.b[sl] = -1; }
  return t;
}
constexpr CandTab CT = make_cand_tab();

#define CEX(a, b) { int _mx = max(a, b); int _mn = min(a, b); a = _mx; b = _mn; }
DEVINL void sort16_desc(int (&v)[16]) {
#pragma unroll
  for (int k = 2; k <= 16; k <<= 1) {
#pragma unroll
    for (int j = k >> 1; j > 0; j >>= 1) {
#pragma unroll
      for (int i = 0; i < 16; i++) {
        const int l = i ^ j;
        if (l > i) {
          if ((i & k) == 0) { CEX(v[i], v[l]); } else { CEX(v[l], v[i]); }
        }
      }
    }
  }
}
DEVINL void merge16_desc(int (&a)[16], const int (&b)[16]) {
#pragma unroll
  for (int i = 0; i < 16; i++) a[i] = max(a[i], b[15 - i]);
#pragma unroll
  for (int j = 8; j > 0; j >>= 1) {
#pragma unroll
    for (int i = 0; i < 16; i++) {
      const int l = i ^ j;
      if (l > i) { CEX(a[i], a[l]); }
    }
  }
}

DEVINL void topk_load_q(const Params& p, int t, int wid, int l15, int g4, uint4 (&q)[8]) {
  const int tile = t >> 3, h = t & 7;
  const u16* qp = p.PQ + (size_t)(tile * 128 + 16 * wid + l15) * 2048 + h * 256 + 8 * g4;
#pragma unroll
  for (int c = 0; c < 2; c++)
#pragma unroll
    for (int ks = 0; ks < 4; ks++) q[c * 4 + ks] = *(const uint4*)(qp + c * 128 + ks * 32);
}
DEVINL void topk_half(const float* SCw, int tk, int qt, int (&top)[16]) {
  const float* sp = SCw + (size_t)tk * 132 + qt * 32;
#pragma unroll
  for (int grp = 0; grp < 2; grp++) {
    int v[16];
#pragma unroll
    for (int i = 0; i < 4; i++) {
      f32x4 x = *(const f32x4*)(sp + grp * 16 + i * 4);
#pragma unroll
      for (int r = 0; r < 4; r++) {
        int kidx = qt * 32 + grp * 16 + i * 4 + r;
        v[i * 4 + r] = (mono(x[r]) & ~0x7F) | (127 - kidx);
      }
    }
    sort16_desc(v);
    if (grp == 0) {
#pragma unroll
      for (int k = 0; k < 16; k++) top[k] = v[k];
    } else {
      merge16_desc(top, v);
    }
  }
  int b[16];
#pragma unroll
  for (int k = 0; k < 16; k++) b[k] = __shfl_xor(top[k], 16);
  merge16_desc(top, b);
#pragma unroll
  for (int k = 0; k < 16; k++) b[k] = __shfl_xor(top[k], 32);
  merge16_desc(top, b);
}
DEVINL void peer_topk_phase(const Params& p, char* smem) {
  const int tid = get_tid(), lane = tid & 63, wid = __builtin_amdgcn_readfirstlane(tid >> 6), l15 = lane & 15, g4 = lane >> 4;
  const int bid = blockIdx.x, nb = gridDim.x;
  char* SK = smem;
  float* SCw = (float*)(smem + 65536 + wid * 8448);
  int* LI = (int*)SCw;
  int h_loaded = -1;
  uint4 qn[8];
  if (bid < 1088) topk_load_q(p, bid, wid, l15, g4, qn);
  for (int t = bid; t < 1088; t += nb) {
    const int tile = t >> 3, h = t & 7;
    if (h != h_loaded) {
      __syncthreads();
#pragma unroll
      for (int i = 0; i < 8; i++) {
        int q = tid + i * 512, r = q >> 4, c = q & 15;
        *(uint4*)(SK + sw256(r, c)) = *(const uint4*)(p.SubK + (size_t)(h * 256 + r) * 128 + c * 8);
      }
      __syncthreads();
      h_loaded = h;
    }
    uint4 qc[8];
#pragma unroll
    for (int i = 0; i < 8; i++) qc[i] = qn[i];
    if (t + nb < 1088) topk_load_q(p, t + nb, wid, l15, g4, qn);
    const int tok0 = tile * 128 + 16 * wid;
    const int tk = lane & 15, qt = lane >> 4;
    int m0[16], m1[16];
#pragma unroll
    for (int c = 0; c < 2; c++) {
      f32x4 acc[8];
#pragma unroll
      for (int i = 0; i < 8; i++) acc[i] = (f32x4){0.f, 0.f, 0.f, 0.f};
#pragma unroll
      for (int ks = 0; ks < 4; ks++) {
        bf16x8 qfr = as_frag(qc[c * 4 + ks]);
#pragma unroll
        for (int kt = 0; kt < 8; kt++) {
          bf16x8 kfr = lds_frag(SK + sw256(c * 128 + 16 * kt + l15, ks * 4 + g4));
          acc[kt] = mfma16(kfr, qfr, acc[kt]);
        }
      }
      __builtin_amdgcn_wave_barrier();
#pragma unroll
      for (int kt = 0; kt < 8; kt++) *(f32x4*)(SCw + (size_t)l15 * 132 + 16 * kt + 4 * g4) = acc[kt];
      __builtin_amdgcn_wave_barrier();
      if (c == 0) topk_half(SCw, tk, qt, m0); else topk_half(SCw, tk, qt, m1);
      __builtin_amdgcn_wave_barrier();
    }
    if (qt < 2) {
      int* dst = LI + (qt * 16 + tk) * 17;
#pragma unroll
      for (int k = 0; k < 16; k++) dst[k] = qt ? m1[k] : m0[k];
    }
    int top[16];
    {
      float v0[16], v1[16];
#pragma unroll
      for (int k = 0; k < 16; k++) { v0[k] = unmono(m0[k] & ~0x7F); v1[k] = unmono(m1[k] & ~0x7F); }
#pragma unroll
      for (int k = 0; k < 16; k++) {
        int key[4];
#pragma unroll
        for (int g = 0; g < 4; g++) {
          const int ca = CT.a[g * 16 + k], cb = CT.b[g * 16 + k];
          if (ca >= 0) {
            float sm = v0[ca] + v1[cb];
            key[g] = (mono(sm) & ~0xFF) | (255 - (ca * 16 + cb));
          } else {
            key[g] = (int)0x80000000;
          }
        }
        int lo = (qt & 1) ? key[1] : key[0];
        int hi = (qt & 1) ? key[3] : key[2];
        top[k] = (qt & 2) ? hi : lo;
      }
      sort16_desc(top);
      int b[16];
#pragma unroll
      for (int k = 0; k < 16; k++) b[k] = __shfl_xor(top[k], 16);
      merge16_desc(top, b);
#pragma unroll
      for (int k = 0; k < 16; k++) b[k] = __shfl_xor(top[k], 32);
      merge16_desc(top, b);
    }
    __builtin_amdgcn_wave_barrier();
    if (qt == 0) {
      const int* l0 = LI + (0 * 16 + tk) * 17;
      const int* l1 = LI + (1 * 16 + tk) * 17;
      float fv[16];
      float sum = 0.f;
      const float mx = unmono(top[0] & ~0xFF);
#pragma unroll
      for (int k = 0; k < 16; k++) { fv[k] = __expf(unmono(top[k] & ~0xFF) - mx); sum += fv[k]; }
      const float inv = 1.0f / sum;
      const size_t ob = ((size_t)(tok0 + tk) * 8 + h) * 16;
#pragma unroll
      for (int k = 0; k < 16; k++) {
        int code = 255 - (top[k] & 0xFF);
        int a = code >> 4, bb = code & 15;
        int i0 = 127 - (l0[a] & 0x7F), i1 = 127 - (l1[bb] & 0x7F);
        p.SELI[ob + k] = i0 * 128 + i1;
        p.SELG[ob + k] = fv[k] * inv;
      }
    }
    __builtin_amdgcn_wave_barrier();
  }
}

typedef float f32x2 __attribute__((ext_vector_type(2)));
#define DEC16(q, f) { f32x2 t_; \
  t_ = __builtin_amdgcn_cvt_pk_f32_fp8((int)(q).x, false); f[0] = t_[0]; f[1] = t_[1]; t_ = __builtin_amdgcn_cvt_pk_f32_fp8((int)(q).x, true); f[2] = t_[0]; f[3] = t_[1]; \
  t_ = __builtin_amdgcn_cvt_pk_f32_fp8((int)(q).y, false); f[4] = t_[0]; f[5] = t_[1]; t_ = __builtin_amdgcn_cvt_pk_f32_fp8((int)(q).y, true); f[6] = t_[0]; f[7] = t_[1]; \
  t_ = __builtin_amdgcn_cvt_pk_f32_fp8((int)(q).z, false); f[8] = t_[0]; f[9] = t_[1]; t_ = __builtin_amdgcn_cvt_pk_f32_fp8((int)(q).z, true); f[10] = t_[0]; f[11] = t_[1]; \
  t_ = __builtin_amdgcn_cvt_pk_f32_fp8((int)(q).w, false); f[12] = t_[0]; f[13] = t_[1]; t_ = __builtin_amdgcn_cvt_pk_f32_fp8((int)(q).w, true); f[14] = t_[0]; f[15] = t_[1]; }

#ifndef NFP8
#define NFP8 4
#endif
DEVINL void peer_gather_phase(const Params& p) {
  const int tid_ = get_tid(); const int lane = tid_ & 63, wid = __builtin_amdgcn_readfirstlane(tid_ >> 6);
  const int kl = ((lane >> 5) & 1) * 8 + ((lane >> 4) & 1) * 4 + ((lane >> 3) & 1) * 2 + ((lane >> 2) & 1);
  for (int t = blockIdx.x * 8 + wid; t < T_ALL; t += gridDim.x * 8) {
    float x[16], out[16];
    {
      const u16* xr = p.Xb + (size_t)t * 1024 + lane * 16;
      uint4 a = *(const uint4*)xr, b = *(const uint4*)(xr + 8);
      unpack8(a, x); unpack8(b, x + 8);
    }
    float out4[16];
    float sumck = 0.f;
#pragma unroll
    for (int j = 0; j < 16; j++) { out[j] = 0.f; out4[j] = 0.f; }
    int xp[2][2];
    float xs;
    {
      float am = 0.f;
#pragma unroll
      for (int j = 0; j < 16; j++) am = fmaxf(am, fabsf(x[j]));
#pragma unroll
      for (int o = 32; o >= 1; o >>= 1) am = fmaxf(am, __shfl_xor(am, o));
      const float xinv = am > 0.f ? 118.0f / am : 0.f;
      xs = am > 0.f ? am / 118.0f : 0.f;
      unsigned pl[2][2] = {{0u, 0u}, {0u, 0u}};
#pragma unroll
      for (int j = 0; j < 16; j++) {
        const int xi = (int)rintf(x[j] * xinv);
        const int n0 = ((xi + 8) & 15) - 8;
        const int n1 = (xi - n0) >> 4;
        pl[0][j >> 3] |= ((unsigned)n0 & 15u) << (4 * (j & 7));
        pl[1][j >> 3] |= ((unsigned)n1 & 15u) << (4 * (j & 7));
      }
#pragma unroll
      for (int q = 0; q < 2; q++) { xp[q][0] = (int)pl[q][0]; xp[q][1] = (int)pl[q][1]; }
    }
#pragma unroll 1
    for (int h = 0; h < 8; h++) {
      const size_t sb = ((size_t)t * 8 + h) * 16;
      const int ei = p.SELI[sb + (lane & 15)];
      const int ekl = p.SELI[sb + kl];
      const float gk = p.SELG[sb + kl];
      const float us = p.Usc[ekl] * xs, vs = (kl >= NFP8) ? p.Vsc4[ekl] : p.Vsc[ekl];
      float part[16];
      {
        uint2 u[16];
#pragma unroll
        for (int k = 0; k < 16; k++) {
          int e = __builtin_amdgcn_readlane(ei, k);
          u[k] = *(const uint2*)(p.Ub4 + (size_t)e * 512 + lane * 8);
        }
#pragma unroll
        for (int k = 0; k < 16; k++) {
          const int d0 = __builtin_amdgcn_sdot8((int)u[k].x, xp[0][0], __builtin_amdgcn_sdot8((int)u[k].y, xp[0][1], 0, false), false);
          const int d1 = __builtin_amdgcn_sdot8((int)u[k].x, xp[1][0], __builtin_amdgcn_sdot8((int)u[k].y, xp[1][1], 0, false), false);
          part[k] = (float)(d0 + 16 * d1);
        }
      }
      float p8[8], p4[4], p2[2], z;
      {
        const bool hi = (lane & 32) != 0;
#pragma unroll
        for (int k = 0; k < 8; k++) {
          float send = hi ? part[k] : part[k + 8];
          float keep = hi ? part[k + 8] : part[k];
          p8[k] = keep + __shfl_xor(send, 32);
        }
      }
      {
        const bool hi = (lane & 16) != 0;
#pragma unroll
        for (int k = 0; k < 4; k++) {
          float send = hi ? p8[k] : p8[k + 4];
          float keep = hi ? p8[k + 4] : p8[k];
          p4[k] = keep + __shfl_xor(send, 16);
        }
      }
      {
        const bool hi = (lane & 8) != 0;
#pragma unroll
        for (int k = 0; k < 2; k++) {
          float send = hi ? p4[k] : p4[k + 2];
          float keep = hi ? p4[k + 2] : p4[k];
          p2[k] = keep + __shfl_xor(send, 8);
        }
      }
      {
        const bool hi = (lane & 4) != 0;
        float send = hi ? p2[0] : p2[1];
        float keep = hi ? p2[1] : p2[0];
        z = keep + __shfl_xor(send, 4);
      }
      z += __shfl_xor(z, 1);
      z += __shfl_xor(z, 2);
      const float co = gk * gelu_tanh(z * us) * vs;
      {
        uint4 v[NFP8];
#pragma unroll
        for (int k = 0; k < NFP8; k++) {
          int e = __builtin_amdgcn_readlane(ei, k);
          v[k] = *(const uint4*)(p.Vb8 + (size_t)e * 1024 + lane * 16);
        }
#pragma unroll
        for (int k = 0; k < NFP8; k++) {
          const int src = ((k >> 3) & 1) * 32 + ((k >> 2) & 1) * 16 + ((k >> 1) & 1) * 8 + (k & 1) * 4;
          const float ck = __int_as_float(__builtin_amdgcn_readlane(__float_as_int(co), src));
          float f[16];
          DEC16(v[k], f);
#pragma unroll
          for (int j = 0; j < 16; j++) out[j] += ck * f[j];
        }
        __builtin_amdgcn_sched_barrier(0);
      }
      {
        uint2 v[16 - NFP8];
#pragma unroll
        for (int k = 0; k < 16 - NFP8; k++) {
          int e = __builtin_amdgcn_readlane(ei, NFP8 + k);
          v[k] = *(const uint2*)(p.Vb4 + (size_t)e * 512 + lane * 8);
        }
#pragma unroll
        for (int k = 0; k < 16 - NFP8; k++) {
          const int kk = NFP8 + k;
          const int src = ((kk >> 3) & 1) * 32 + ((kk >> 2) & 1) * 16 + ((kk >> 1) & 1) * 8 + (kk & 1) * 4;
          const float ck = __int_as_float(__builtin_amdgcn_readlane(__float_as_int(co), src));
          const unsigned ckb = pk2(ck, 0.f) & 0xffffu;
          union { unsigned u; bf16v2 h; } blo, bhi, tt;
          blo.u = ckb; bhi.u = ckb << 16;
          sumck += __uint_as_float(ckb << 16);
#pragma unroll
          for (int w = 0; w < 2; w++) {
            const unsigned wd = w ? v[k].y : v[k].x;
#pragma unroll
            for (int i = 0; i < 4; i++) {
              tt.u = ((wd >> (4 * i)) & 0x000F000Fu) | 0x43004300u;
              out4[8 * w + i] = __builtin_amdgcn_fdot2_f32_bf16(tt.h, blo.h, out4[8 * w + i], false);
              out4[8 * w + i + 4] = __builtin_amdgcn_fdot2_f32_bf16(tt.h, bhi.h, out4[8 * w + i + 4], false);
            }
          }
        }
        __builtin_amdgcn_sched_barrier(0);
      }
    }
#pragma unroll
    for (int j = 0; j < 16; j++) out[j] += out4[j] - 136.0f * sumck;
    float s = 0.f;
#pragma unroll
    for (int j = 0; j < 16; j++) { out[j] = ALPHA_F * x[j] + out[j]; s += out[j]; }
    const float mean = wave_sum(s) * (1.0f / 1024.0f);
    float q = 0.f;
#pragma unroll
    for (int j = 0; j < 16; j++) { float d = out[j] - mean; q += d * d; }
    const float rstd = rsqrtf(wave_sum(q) * (1.0f / 1024.0f) + LN_EPS_F);
    float* yr = p.Y + (size_t)t * 1024 + lane * 16;
    const float* gp = p.ln3_g + lane * 16;
    const float* bp = p.ln3_b + lane * 16;
#pragma unroll
    for (int i = 0; i < 4; i++) {
      float4 g = *(const float4*)(gp + i * 4), b = *(const float4*)(bp + i * 4);
      float4 y;
      y.x = (out[i * 4 + 0] - mean) * rstd * g.x + b.x; y.y = (out[i * 4 + 1] - mean) * rstd * g.y + b.y;
      y.z = (out[i * 4 + 2] - mean) * rstd * g.z + b.z; y.w = (out[i * 4 + 3] - mean) * rstd * g.w + b.w;
      *(float4*)(yr + i * 4) = y;
    }
  }
}

struct KArgs { const float* in[28]; float* out; char* ws; int flags; int pad; };

constexpr size_t al256(size_t b) { return (b + 255) & ~(size_t)255; }
constexpr size_t OFF_BAR = 0;
constexpr size_t OFF_WINT = OFF_BAR + 16384;
constexpr size_t OFF_WOT = OFF_WINT + al256((size_t)3072 * 1024 * 2);
constexpr size_t OFF_WQT = OFF_WOT + al256((size_t)1024 * 1024 * 2);
constexpr size_t OFF_WKVT = OFF_WQT + al256((size_t)1024 * 1024 * 2);
constexpr size_t OFF_WCOT = OFF_WKVT + al256((size_t)2048 * 1024 * 2);
constexpr size_t OFF_PWQT = OFF_WCOT + al256((size_t)1024 * 1024 * 2);
constexpr size_t OFF_SUBK = OFF_PWQT + al256((size_t)2048 * 1024 * 2);
constexpr size_t OFF_UB = OFF_SUBK + al256((size_t)262144 * 2);
constexpr size_t OFF_VB = OFF_UB + al256((size_t)16384 * 1024 * 2);
constexpr size_t OFF_XB = OFF_VB + al256((size_t)16384 * 1024 * 2);
constexpr size_t OFF_MEMB = OFF_XB + al256((size_t)T_ALL * 1024 * 2);
constexpr size_t OFF_HB = OFF_MEMB + al256((size_t)2048 * 1024 * 2);
constexpr size_t OFF_MEMKVB = OFF_HB + al256((size_t)T_ALL * 3072 * 2);
constexpr size_t OFF_RCOS = OFF_MEMKVB + al256((size_t)2048 * 2048 * 2);
constexpr size_t OFF_RSIN = OFF_RCOS + al256((size_t)2056 * 64 * 4);
constexpr size_t OFF_U = OFF_RSIN + al256((size_t)2056 * 64 * 4);
constexpr size_t OFF_MIXIN = OFF_U + al256((size_t)512 * 16384 * 4);
constexpr size_t OFF_PRE = OFF_MIXIN + al256((size_t)T_ALL * 1024 * 2);
constexpr size_t OFF_XF = OFF_PRE + al256((size_t)T_ALL * 1024 * 4);
constexpr size_t OFF_SELI = OFF_XF + al256((size_t)T_ALL * 1024 * 4);
constexpr size_t OFF_SELG = OFF_SELI + al256((size_t)T_ALL * 128 * 4);
constexpr size_t OFF_QKR = OFF_SELG + al256((size_t)T_ALL * 128 * 4);
constexpr size_t WS_TOTAL = OFF_QKR + al256((size_t)T_P * 1024 * 2);

DEVINL Params make_view(const KArgs& ka) {
  Params p;
  p.x_prompt = ka.in[0]; p.x_sample = ka.in[1]; p.mem_prompt = ka.in[2]; p.cache_k = ka.in[3]; p.cache_v = ka.in[4]; p.state_ret = ka.in[5];
  p.w_in = ka.in[6]; p.w_s = ka.in[7]; p.b_s = ka.in[8]; p.gate_ln_g = ka.in[9]; p.gate_ln_b = ka.in[10]; p.ret_gn_g = ka.in[11];
  p.ret_gn_b = ka.in[12]; p.w_o = ka.in[13]; p.ln1_g = ka.in[14]; p.ln1_b = ka.in[15]; p.ca_wq = ka.in[16]; p.ca_wk = ka.in[17];
  p.ca_wv = ka.in[18]; p.ca_wo = ka.in[19]; p.ln2_g = ka.in[20]; p.ln2_b = ka.in[21]; p.peer_wq = ka.in[22]; p.peer_subkeys = ka.in[23];
  p.peer_u = ka.in[24]; p.peer_v = ka.in[25]; p.ln3_g = ka.in[26]; p.ln3_b = ka.in[27];
  float* o = ka.out;
  p.Y = o;
  p.new_mem_k = o + (size_t)T_ALL * 1024;
  p.new_mem_v = p.new_mem_k + (size_t)2048 * 1024;
  p.new_ret_prompt = p.new_mem_v + (size_t)2048 * 1024;
  p.new_ret_sample = p.new_ret_prompt + (size_t)32 * 16384;
  p.new_gate_v = p.new_ret_sample + (size_t)512 * 16384;
  char* w = ka.ws;
  p.bar = (unsigned*)(w + OFF_BAR);
  p.WinT = (u16*)(w + OFF_WINT); p.WoT = (u16*)(w + OFF_WOT); p.WqT = (u16*)(w + OFF_WQT); p.WkvT = (u16*)(w + OFF_WKVT);
  p.WcoT = (u16*)(w + OFF_WCOT); p.PwqT = (u16*)(w + OFF_PWQT); p.SubK = (u16*)(w + OFF_SUBK); p.Ub = (u16*)(w + OFF_UB);
  p.Vb = (u16*)(w + OFF_VB);
  p.Ub8 = (unsigned char*)(w + OFF_UB); p.Ub4 = p.Ub8; p.Usc = (float*)(w + OFF_UB + (size_t)16384 * 1024);
  p.Vb8 = (unsigned char*)(w + OFF_VB); p.Vsc = (float*)(w + OFF_VB + (size_t)16384 * 1024);
  p.Vb4 = (unsigned char*)(w + OFF_VB + (size_t)20 * 1024 * 1024); p.Vsc4 = (float*)(w + OFF_VB + (size_t)30 * 1024 * 1024); p.Xb = (u16*)(w + OFF_XB); p.Memb = (u16*)(w + OFF_MEMB); p.Hb = (u16*)(w + OFF_HB);
  p.QC = p.Hb; p.PQ = p.Hb + (size_t)T_ALL * 1024;
  p.MemKVb = (u16*)(w + OFF_MEMKVB); p.rope_cos = (float*)(w + OFF_RCOS); p.rope_sin = (float*)(w + OFF_RSIN);
  p.U = (float*)(w + OFF_U); p.MIXIN = (u16*)(w + OFF_MIXIN); p.CA = p.MIXIN; p.PREb = (u16*)(w + OFF_PRE); p.SP = (u16*)(w + OFF_XF);
  p.SELI = (int*)(w + OFF_SELI); p.SELG = (float*)(w + OFF_SELG); p.QKR = (u16*)(w + OFF_QKR);
  return p;
}

__global__ void __launch_bounds__(NT) fwd_megakernel(KArgs ka) {
  __shared__ __attribute__((aligned(16))) char smem[SMEM_BYTES];
  __shared__ uint4 xb_words;
  if (threadIdx.x == 0) xb_words = make_uint4(0u, 0u, 0u, 0u);
  __syncthreads();
  const Params p = make_view(ka);
  XcdBarrier xb = xcd_barrier_post(p.bar, (volatile LAS unsigned*)&xb_words);
  const int bid = blockIdx.x, nb = gridDim.x;
  unsigned epoch = 0;

#if PH(0)
  RPT(0) prep_phase(p, smem);
#endif
  if (ka.flags & 1) cg::this_grid().sync();
  grid_barrier(p, epoch);

#if PH(1)
  {
    gemm_run<256>(p.Xb, p.WinT, bid, 1632, nb, [&](int t, int& m0, int& n0) { int mt = t / 12; m0 = mt * 128; n0 = (t - mt * 12) * 256; }, smem,
      [&](int m, int n, f32x4 v) {
        if (n < 1024) { v[0] = gelu_tanh(v[0]); v[1] = gelu_tanh(v[1]); v[2] = gelu_tanh(v[2]); v[3] = gelu_tanh(v[3]); }
        else if (n >= 2560) { v[0] = silu_f(v[0]); v[1] = silu_f(v[1]); v[2] = silu_f(v[2]); v[3] = silu_f(v[3]); }
        uint2 o; o.x = pk2(v[0], v[1]); o.y = pk2(v[2], v[3]);
        *(uint2*)(p.Hb + (size_t)m * 3072 + n) = o;
      });
    gemm_run<256>(p.Memb, p.WkvT, first_ge(bid, nb, 1632), 1760, nb, [&](int t, int& m0, int& n0) { int u = t - 1632; m0 = (u >> 3) * 128; n0 = (u & 7) * 256; }, smem,
      [&](int m, int n, f32x4 v) {
        float* dst = (n < 1024) ? (p.new_mem_k + (size_t)m * 1024 + n) : (p.new_mem_v + (size_t)m * 1024 + (n - 1024));
        *(f32x4*)dst = v;
        uint2 o; o.x = pk2(v[0], v[1]); o.y = pk2(v[2], v[3]);
        *(uint2*)(p.MemKVb + (size_t)m * 2048 + n) = o;
      });
  }
#endif
  grid_barrier(p, epoch);

#if PH(2)
  RPT(2) for (int t = bid; t < 1664; t += nb) {
    if (t < 512) r1_item(p, t, smem);
    else if (t < 1024) gate_prompt_item(p, t - 512, smem);
    else if (t < 1536) ret_sample_item(p, t - 1024, smem);
    else gate_sample_item(p, t - 1536, smem);
  }
#endif
  grid_barrier(p, epoch);

  for (int t = bid; t < 256; t += nb) ret_scan_item(p, t);
  grid_barrier(p, epoch);

#if PH(3)
  RPT(3) for (int t = bid; t < 512; t += nb) r3_item(p, t, smem);
#endif
  grid_barrier(p, epoch);

#if PH(4)
  {
    auto epi4 = [&](int m, int n, f32x4 v) {
      float4 xr = *(const float4*)(xin_row(p, m) + n);
      uint2 o; o.x = pk2(ALPHA_F * xr.x + v[0], ALPHA_F * xr.y + v[1]); o.y = pk2(ALPHA_F * xr.z + v[2], ALPHA_F * xr.w + v[3]);
      *(uint2*)(p.PREb + (size_t)m * 1024 + n) = o;
    };
    gemm_run<256>(p.MIXIN, p.WoT, bid, 512, nb, [&](int t, int& m0, int& n0) { m0 = (t >> 2) * 128; n0 = (t & 3) * 256; }, smem, epi4);
    gemm_run<128>(p.MIXIN, p.WoT, first_ge(bid, nb, 512), 576, nb, [&](int t, int& m0, int& n0) { int u = t - 512; m0 = (128 + (u >> 3)) * 128; n0 = (u & 7) * 128; }, smem, epi4);
    if (bid >= 64) quant_rows(p, 0, 10923, bid - 64, nb - 64);
  }
#endif
  grid_barrier(p, epoch);

  RPT(5) ln_phase(p.PREb, p.ln1_g, p.ln1_b, p.Xb);
  grid_barrier(p, epoch);

#if PH(6)
  {
    auto epi6 = [&](int m, int n, f32x4 v) {
      uint2 o; o.x = pk2(v[0] * 0.0625f, v[1] * 0.0625f); o.y = pk2(v[2] * 0.0625f, v[3] * 0.0625f);
      *(uint2*)(p.QC + (size_t)m * 1024 + n) = o;
    };
    gemm_run<256>(p.Xb, p.WqT, bid, 512, nb, [&](int t, int& m0, int& n0) { m0 = (t >> 2) * 128; n0 = (t & 3) * 256; }, smem, epi6);
    gemm_run<128>(p.Xb, p.WqT, first_ge(bid, nb, 512), 576, nb, [&](int t, int& m0, int& n0) { int u = t - 512; m0 = (128 + (u >> 3)) * 128; n0 = (u & 7) * 128; }, smem, epi6);
    if (bid >= 64) quant_rows(p, 10923, 21846, bid - 64, nb - 64);
  }
#endif
  grid_barrier(p, epoch);

#if PH(7)
  if ((nb & 1) == 0) {
    const int half = nb >> 1, hb = bid >> 1;
    if ((bid & 1) == 0) {
      for (int u = hb; u < 256; u += half) attn_pair_prompt(p, (u >> 3) >> 2, (u >> 3) & 3, 2 * (u & 7), smem);
    }
    else { for (int t = hb; t < 512; t += half) attn_item(p, 512 + t, smem); }
  } else {
    for (int t = bid; t < 1024; t += nb) attn_item(p, t, smem);
  }
#endif
  grid_barrier(p, epoch);

#if PH(8)
  {
    auto epi8 = [&](int m, int n, f32x4 v) {
      uint2 xr = *(const uint2*)(p.Xb + (size_t)m * 1024 + n);
      uint2 o; o.x = pk2(ALPHA_F * bflo(xr.x) + v[0], ALPHA_F * bfhi(xr.x) + v[1]); o.y = pk2(ALPHA_F * bflo(xr.y) + v[2], ALPHA_F * bfhi(xr.y) + v[3]);
      *(uint2*)(p.PREb + (size_t)m * 1024 + n) = o;
    };
    gemm_run<256>(p.CA, p.WcoT, bid, 512, nb, [&](int t, int& m0, int& n0) { m0 = (t >> 2) * 128; n0 = (t & 3) * 256; }, smem, epi8);
    gemm_run<128>(p.CA, p.WcoT, first_ge(bid, nb, 512), 576, nb, [&](int t, int& m0, int& n0) { int u = t - 512; m0 = (128 + (u >> 3)) * 128; n0 = (u & 7) * 128; }, smem, epi8);
    if (bid >= 64) quant_rows(p, 21846, 32768, bid - 64, nb - 64);
  }
#endif
  grid_barrier(p, epoch);

  RPT(9) ln_phase(p.PREb, p.ln2_g, p.ln2_b, p.Xb);
  grid_barrier(p, epoch);

#if PH(10)
  {
    auto epi10 = [&](int m, int n, f32x4 v) {
      uint2 o; o.x = pk2(v[0], v[1]); o.y = pk2(v[2], v[3]);
      *(uint2*)(p.PQ + (size_t)m * 2048 + n) = o;
    };
    gemm_run<256>(p.Xb, p.PwqT, bid, 1024, nb, [&](int t, int& m0, int& n0) { m0 = (t >> 3) * 128; n0 = (t & 7) * 256; }, smem, epi10);
    gemm_run<128>(p.Xb, p.PwqT, first_ge(bid, nb, 1024), 1152, nb, [&](int t, int& m0, int& n0) { int u = t - 1024; m0 = (128 + (u >> 4)) * 128; n0 = (u & 15) * 128; }, smem, epi10);
  }
#endif
  grid_barrier(p, epoch);

#if PH(11)
  __syncthreads();
  RPT(11) peer_topk_phase(p, smem);
#endif
  grid_barrier(p, epoch);

#if PH(12)
  RPT(12) peer_gather_phase(p);
#endif
}

extern "C" void kernel_launch(void* const* d_in, const int* in_sizes, int n_in, void* d_out, int out_size, void* d_ws,
                              size_t ws_size, hipStream_t stream) {
  (void)in_sizes; (void)n_in; (void)out_size;
  KArgs ka;
  memset(&ka, 0, sizeof(ka));
  for (int i = 0; i < 28; i++) ka.in[i] = (const float*)d_in[i];
  ka.out = (float*)d_out;
  ka.ws = (char*)d_ws;
  if (ws_size < WS_TOTAL) fprintf(stderr, "workspace too small: %zu < %zu\n", ws_size, (size_t)WS_TOTAL);
  static int grid_blocks = 0;
  if (!grid_blocks) {
    int dev = 0, cus = 0, per_cu = 0;
    hipGetDevice(&dev);
    hipDeviceGetAttribute(&cus, hipDeviceAttributeMultiprocessorCount, dev);
    hipOccupancyMaxActiveBlocksPerMultiprocessor(&per_cu, fwd_megakernel, NT, 0);
    if (per_cu < 1) per_cu = 1;
    if (per_cu > 1) per_cu = 1;
    grid_blocks = cus * per_cu;
  }
  hipMemsetAsync(ka.ws + OFF_BAR, 0, XCD_BAR_WORDS * 4, stream);
  void* args[] = {&ka};
  hipError_t e = hipLaunchCooperativeKernel((void*)fwd_megakernel, dim3(grid_blocks), dim3(NT), args, 0, stream);
  if (e != hipSuccess) fprintf(stderr, "cooperative launch failed: %s (grid %d)\n", hipGetErrorString(e), grid_blocks);
}
```

```cpp
#include <hip/hip_runtime.h>
#include <hip/hip_cooperative_groups.h>
#include <cstdio>
#include <cstdint>
#include <cstring>
namespace cg = cooperative_groups;

#define NT 512
#define DEVINL __device__ __forceinline__
#ifndef PHASES
#define PHASES 0xFFFF
#endif
#define PH(k) ((PHASES >> (k)) & 1)
#ifndef RPT_MASK
#define RPT_MASK 0x0
#endif
#define RPT(k) for (int rep_ = 0; rep_ < 1 + ((RPT_MASK >> (k)) & 1); rep_++)
#ifndef USE_CG_SYNC
#define USE_CG_SYNC 0
#endif

typedef unsigned short u16;
typedef short bf16x8 __attribute__((ext_vector_type(8)));
typedef short s4v __attribute__((ext_vector_type(4)));
typedef float f32x4 __attribute__((ext_vector_type(4)));

constexpr int T_ALL = 17408;
constexpr int T_P = 16384;
constexpr float ALPHA_F = 1.189207115002721f;
constexpr float LN_EPS_F = 1e-5f;
constexpr int SMEM_BYTES = 139264;

struct Params {
  const float *x_prompt, *x_sample, *mem_prompt, *cache_k, *cache_v, *state_ret, *w_in, *w_s, *b_s,
      *gate_ln_g, *gate_ln_b, *ret_gn_g, *ret_gn_b, *w_o, *ln1_g, *ln1_b, *ca_wq, *ca_wk, *ca_wv, *ca_wo,
      *ln2_g, *ln2_b, *peer_wq, *peer_subkeys, *peer_u, *peer_v, *ln3_g, *ln3_b;
  float *Y, *new_mem_k, *new_mem_v, *new_ret_prompt, *new_ret_sample, *new_gate_v;
  unsigned char *Ub8, *Vb8, *Ub4, *Vb4;
  float* Vsc4;
  float *Usc, *Vsc;
  u16 *QKR, *WinT, *WoT, *WqT, *WkvT, *WcoT, *PwqT, *SubK, *Ub, *Vb, *Xb, *Memb, *Hb, *MemKVb, *MIXIN, *QC, *CA, *PQ;
  float *rope_cos, *rope_sin, *U, *SELG;
  u16* PREb;
  u16* SP;
  int* SELI;
  unsigned* bar;
};

typedef __bf16 bf16v2 __attribute__((ext_vector_type(2)));
typedef float f32v2 __attribute__((ext_vector_type(2)));
DEVINL unsigned pk2(float a, float b) {
  f32v2 v = {a, b};
  union { bf16v2 h; unsigned u; } c;
  c.h = __builtin_convertvector(v, bf16v2);
  return c.u;
}
DEVINL u16 f2bf(float f) { return (u16)(pk2(f, 0.f) & 0xffffu); }
DEVINL float bflo(unsigned u) { return __uint_as_float(u << 16); }
DEVINL float bfhi(unsigned u) { return __uint_as_float(u & 0xffff0000u); }
DEVINL float bf1(u16 h) { return __uint_as_float(((unsigned)h) << 16); }
DEVINL void unpack8(const uint4& r, float* x) {
  x[0] = bflo(r.x); x[1] = bfhi(r.x); x[2] = bflo(r.y); x[3] = bfhi(r.y);
  x[4] = bflo(r.z); x[5] = bfhi(r.z); x[6] = bflo(r.w); x[7] = bfhi(r.w);
}
DEVINL uint4 pack8(const float* x) {
  uint4 o; o.x = pk2(x[0], x[1]); o.y = pk2(x[2], x[3]); o.z = pk2(x[4], x[5]); o.w = pk2(x[6], x[7]);
  return o;
}
DEVINL bf16x8 as_frag(const uint4& r) {
  union { uint4 u; bf16x8 f; } c; c.u = r; return c.f;
}
DEVINL f32x4 mfma16(bf16x8 a, bf16x8 b, f32x4 c) { return __builtin_amdgcn_mfma_f32_16x16x32_bf16(a, b, c, 0, 0, 0); }
DEVINL float gelu_tanh(float x) {
  float u = 0.7978845608028654f * (x + 0.044715f * x * x * x);
  float e = __expf(2.0f * u);
  float t = 1.0f - 2.0f * __builtin_amdgcn_rcpf(e + 1.0f);
  return 0.5f * x * (1.0f + t);
}
DEVINL float silu_f(float x) { return x * __builtin_amdgcn_rcpf(1.0f + __expf(-x)); }
DEVINL int sw128(int r, int c) { return r * 128 + ((c ^ (r & 7)) << 4); }
DEVINL int sw256(int r, int c) { return r * 256 + ((c ^ (r & 15)) << 4); }
DEVINL int sw512(int r, int c) { return r * 512 + ((c ^ (r & 15)) << 4); }
DEVINL bf16x8 lds_frag(const char* p) { return *(const bf16x8*)p; }
DEVINL s4v tr_read(const char* p) {
  return __builtin_amdgcn_ds_read_tr16_b64_v4i16((__attribute__((address_space(3))) s4v*)p);
}
DEVINL bf16x8 tr_frag(const char* base, int stride, int k0, int c0, int lane) {
  int grp = lane >> 4, q = (lane >> 2) & 3, pp = lane & 3;
  const char* a0 = base + (k0 + 8 * grp + q) * stride + (c0 + 4 * pp) * 2;
  s4v lo = tr_read(a0), hi = tr_read(a0 + 4 * stride);
  bf16x8 r; r[0] = lo[0]; r[1] = lo[1]; r[2] = lo[2]; r[3] = lo[3]; r[4] = hi[0]; r[5] = hi[1]; r[6] = hi[2]; r[7] = hi[3];
  return r;
}
DEVINL bf16x8 tr_frag_perm(const char* base, int stride, int k0, int c0, int lane) {
  int grp = lane >> 4, q = (lane >> 2) & 3, pp = lane & 3;
  const char* a0 = base + (k0 + 4 * grp + q) * stride + (c0 + 4 * pp) * 2;
  s4v lo = tr_read(a0), hi = tr_read(a0 + 16 * stride);
  bf16x8 r; r[0] = lo[0]; r[1] = lo[1]; r[2] = lo[2]; r[3] = lo[3]; r[4] = hi[0]; r[5] = hi[1]; r[6] = hi[2]; r[7] = hi[3];
  return r;
}
DEVINL bf16x8 pack_frag(const f32x4& a, const f32x4& b) {
  uint4 o; o.x = pk2(a[0], a[1]); o.y = pk2(a[2], a[3]); o.z = pk2(b[0], b[1]); o.w = pk2(b[2], b[3]);
  return as_frag(o);
}
DEVINL float wave_sum(float v) {
#pragma unroll
  for (int o = 32; o >= 1; o >>= 1) v += __shfl_xor(v, o);
  return v;
}
DEVINL const float* xin_row(const Params& p, int m) {
  return (m < T_P) ? (p.x_prompt + (size_t)m * 1024) : (p.x_sample + (size_t)(m - T_P) * 1024);
}

DEVINL int get_tid() { int t = threadIdx.x; asm volatile("" : "+v"(t)); return t; }

#define XB_TMO      128
#define XB_XCNT(j)  (256  + 64 * (j))
#define XB_XSUB(j)  (1280 + 64 * (j))
#define XB_XGEN(j)  (2304 + 64 * (j))
#define XB_TOP      3328
#define XB_TOPGEN   3392
#define XCD_BAR_WORDS 3456
#define XB_SPIN_CAP (1u << 22)
#define LAS __attribute__((address_space(3)))
DEVINL unsigned xb_ld(unsigned* p) { return __hip_atomic_load(p, __ATOMIC_RELAXED, __HIP_MEMORY_SCOPE_AGENT); }
DEVINL unsigned xb_add(unsigned* p, unsigned v) { return __hip_atomic_fetch_add(p, v, __ATOMIC_RELAXED, __HIP_MEMORY_SCOPE_AGENT); }
DEVINL unsigned xb_xcc_id() { return (unsigned)__builtin_amdgcn_s_getreg((3 << 11) | 20) & 0xFu; }
#define XB_SPIN(cond, bar) do { unsigned _sp = 0; while (cond) { __builtin_amdgcn_s_sleep(1); \
    if ((++_sp & 255u) == 0u) { if (xb_ld(&(bar)[XB_TMO])) break; if (_sp > XB_SPIN_CAP) { atomicAdd(&(bar)[XB_TMO], 1u); break; } } } } while (0)
struct XcdBarrier { unsigned* bar; unsigned x; volatile LAS unsigned* st; };
DEVINL XcdBarrier xcd_barrier_post(unsigned* bar, volatile LAS unsigned* st) {
  XcdBarrier b; b.bar = bar; b.x = xb_xcc_id(); b.st = st;
  if (threadIdx.x == 0) (void)xb_add(&bar[XB_XCNT(b.x)], 1u);
  return b;
}
DEVINL void xcd_barrier_complete(unsigned* bar, unsigned x, unsigned& nloc, unsigned& nx) {
  const unsigned G = gridDim.x * gridDim.y * gridDim.z;
  unsigned sum, cnt, mine, sp = 0u;
  for (;;) {
    sum = 0u; cnt = 0u; mine = 0u;
#pragma unroll
    for (unsigned j = 0; j < 16; ++j) { const unsigned c = xb_ld(&bar[XB_XCNT(j)]); sum += c; cnt += (c > 0u) ? 1u : 0u; mine = (j == x) ? c : mine; }
    if (sum == G) break;
    __builtin_amdgcn_s_sleep(1);
    if ((++sp & 255u) == 0u) { if (xb_ld(&bar[XB_TMO])) break; if (sp > XB_SPIN_CAP) { atomicAdd(&bar[XB_TMO], 1u); break; } }
  }
  nloc = mine > 0u ? mine : 1u; nx = cnt > 0u ? cnt : 1u;
}
DEVINL void xcd_barrier(const XcdBarrier& b) {
  asm volatile("s_waitcnt vmcnt(0)" ::: "memory");
  __syncthreads();
  if (threadIdx.x == 0) {
    unsigned* bar = b.bar;
    __builtin_amdgcn_s_waitcnt(0);
    unsigned nloc = b.st[0], nx = b.st[1];
    if (nloc == 0u) { xcd_barrier_complete(bar, b.x, nloc, nx); b.st[0] = nloc; b.st[1] = nx; }
    const unsigned old = xb_add(&bar[XB_XSUB(b.x)], 1u);
    const unsigned gen = old / nloc;
    if (old + 1u == (gen + 1u) * nloc) {
      __builtin_amdgcn_fence(__ATOMIC_RELEASE, "agent");
      asm volatile("s_waitcnt vmcnt(0)" ::: "memory");
      const unsigned og = xb_add(&bar[XB_TOP], 1u);
      const unsigned tg = og / nx;
      if (og + 1u == (tg + 1u) * nx) xb_add(&bar[XB_TOPGEN], 1u);
      else XB_SPIN(xb_ld(&bar[XB_TOPGEN]) == tg, bar);
      __builtin_amdgcn_fence(__ATOMIC_ACQUIRE, "agent");
      xb_add(&bar[XB_XGEN(b.x)], 1u);
      asm volatile("s_waitcnt vmcnt(0)" ::: "memory");
    } else {
      XB_SPIN(xb_ld(&bar[XB_XGEN(b.x)]) == gen, bar);
      __builtin_amdgcn_fence(__ATOMIC_ACQUIRE, "agent");
      asm volatile("s_waitcnt vmcnt(0)" ::: "memory");
    }
  }
  __syncthreads();
}
#define grid_barrier(p, epoch) xcd_barrier(xb)

DEVINL void cvt_range(const float* __restrict__ src, u16* __restrict__ dst, size_t n8) {
  size_t stride = (size_t)gridDim.x * NT;
  const int tid_ = get_tid();
  for (size_t i = (size_t)blockIdx.x * NT + tid_; i < n8; i += stride) {
    float4 a = ((const float4*)src)[2 * i], b = ((const float4*)src)[2 * i + 1];
    uint4 o; o.x = pk2(a.x, a.y); o.y = pk2(a.z, a.w); o.z = pk2(b.x, b.y); o.w = pk2(b.z, b.w);
    ((uint4*)dst)[i] = o;
  }
}
DEVINL void transpose_tile(const float* __restrict__ W, int N, u16* __restrict__ WT, int tile, float* tl) {
  const int tid = get_tid();
  int ntn = N >> 6;
  int kt = tile / ntn, nt = tile - kt * ntn;
  int k0 = kt * 64, n0 = nt * 64;
#pragma unroll
  for (int i = 0; i < 2; i++) {
    int r = (tid >> 4) + 32 * i, c4 = (tid & 15) * 4;
    float4 v = *(const float4*)(W + (size_t)(k0 + r) * N + n0 + c4);
    tl[(c4 + 0) * 65 + r] = v.x; tl[(c4 + 1) * 65 + r] = v.y; tl[(c4 + 2) * 65 + r] = v.z; tl[(c4 + 3) * 65 + r] = v.w;
  }
  __syncthreads();
  {
    int n = tid >> 3, k8 = (tid & 7) * 8;
    float x[8];
#pragma unroll
    for (int j = 0; j < 8; j++) x[j] = tl[n * 65 + k8 + j];
    *(uint4*)(WT + (size_t)(n0 + n) * 1024 + k0 + k8) = pack8(x);
  }
  __syncthreads();
}
DEVINL void quant_rows(const Params& p, int r0, int r1, int hb, int nh) {
  const int tid_ = get_tid(); const int lane = tid_ & 63, wid = __builtin_amdgcn_readfirstlane(tid_ >> 6);
  for (int rr = r0 + hb * 8 + wid; rr < r1; rr += nh * 8) {
    const bool isv = rr >= 16384;
    const int row = isv ? rr - 16384 : rr;
    const float* src = isv ? p.peer_v : p.peer_u;
    unsigned char* dst = isv ? p.Vb8 : p.Ub8;
    float* inv_scale = isv ? p.Vsc : p.Usc;
    const float* rp = src + (size_t)row * 1024 + lane * 16;
    float4 a = *(const float4*)rp, b = *(const float4*)(rp + 4), c = *(const float4*)(rp + 8), d = *(const float4*)(rp + 12);
    float m = fmaxf(fmaxf(fmaxf(fabsf(a.x), fabsf(a.y)), fmaxf(fabsf(a.z), fabsf(a.w))), fmaxf(fmaxf(fabsf(b.x), fabsf(b.y)), fmaxf(fabsf(b.z), fabsf(b.w))));
    m = fmaxf(m, fmaxf(fmaxf(fmaxf(fabsf(c.x), fabsf(c.y)), fmaxf(fabsf(c.z), fabsf(c.w))), fmaxf(fmaxf(fabsf(d.x), fabsf(d.y)), fmaxf(fabsf(d.z), fabsf(d.w)))));
#pragma unroll
    for (int o = 32; o >= 1; o >>= 1) m = fmaxf(m, __shfl_xor(m, o));
    if (isv) {
      const float sc = m > 0.f ? 224.0f / m : 1.0f;
      uint4 q;
      int w0 = 0, w1 = 0, w2 = 0, w3 = 0;
      w0 = __builtin_amdgcn_cvt_pk_fp8_f32(a.x * sc, a.y * sc, w0, false); w0 = __builtin_amdgcn_cvt_pk_fp8_f32(a.z * sc, a.w * sc, w0, true);
      w1 = __builtin_amdgcn_cvt_pk_fp8_f32(b.x * sc, b.y * sc, w1, false); w1 = __builtin_amdgcn_cvt_pk_fp8_f32(b.z * sc, b.w * sc, w1, true);
      w2 = __builtin_amdgcn_cvt_pk_fp8_f32(c.x * sc, c.y * sc, w2, false); w2 = __builtin_amdgcn_cvt_pk_fp8_f32(c.z * sc, c.w * sc, w2, true);
      w3 = __builtin_amdgcn_cvt_pk_fp8_f32(d.x * sc, d.y * sc, w3, false); w3 = __builtin_amdgcn_cvt_pk_fp8_f32(d.z * sc, d.w * sc, w3, true);
      q.x = (unsigned)w0; q.y = (unsigned)w1; q.z = (unsigned)w2; q.w = (unsigned)w3;
      *(uint4*)(dst + (size_t)row * 1024 + lane * 16) = q;
      if (lane == 0) inv_scale[row] = m > 0.f ? m / 224.0f : 1.0f;
    }
    {
      const float xv[16] = {a.x, a.y, a.z, a.w, b.x, b.y, b.z, b.w, c.x, c.y, c.z, c.w, d.x, d.y, d.z, d.w};
      float ss = 0.f;
#pragma unroll
      for (int i = 0; i < 16; i++) ss += xv[i] * xv[i];
      ss = wave_sum(ss);
      float clipv = 2.6f * sqrtf(ss * (1.0f / 1024.0f));
      clipv = fminf(clipv, m);
      const float sc = clipv > 0.f ? 7.0f / clipv : 1.0f;
      unsigned w0 = 0u, w1 = 0u;
#pragma unroll
      for (int i = 0; i < 8; i++) {
        int q0 = (int)rintf(xv[i] * sc), q1 = (int)rintf(xv[i + 8] * sc);
        q0 = q0 < -7 ? -7 : (q0 > 7 ? 7 : q0); q1 = q1 < -7 ? -7 : (q1 > 7 ? 7 : q1);
        w0 |= (isv ? (unsigned)(q0 + 8) : ((unsigned)q0 & 15u)) << (4 * i);
        w1 |= (isv ? (unsigned)(q1 + 8) : ((unsigned)q1 & 15u)) << (4 * i);
      }
      *(uint2*)((isv ? p.Vb4 : p.Ub4) + (size_t)row * 512 + lane * 8) = make_uint2(w0, w1);
      if (lane == 0) (isv ? p.Vsc4 : p.Usc)[row] = clipv > 0.f ? clipv / 7.0f : 1.0f;
    }
  }
}
DEVINL void prep_phase(const Params& p, char* smem) {
  float* tl = (float*)smem;
  for (int t = blockIdx.x; t < 2560; t += gridDim.x) {
    if (t < 768) transpose_tile(p.w_in, 3072, p.WinT, t, tl);
    else if (t < 1024) transpose_tile(p.w_o, 1024, p.WoT, t - 768, tl);
    else if (t < 1280) transpose_tile(p.ca_wq, 1024, p.WqT, t - 1024, tl);
    else if (t < 1536) transpose_tile(p.ca_wk, 1024, p.WkvT, t - 1280, tl);
    else if (t < 1792) transpose_tile(p.ca_wv, 1024, p.WkvT + (size_t)1024 * 1024, t - 1536, tl);
    else if (t < 2048) transpose_tile(p.ca_wo, 1024, p.WcoT, t - 1792, tl);
    else transpose_tile(p.peer_wq, 2048, p.PwqT, t - 2048, tl);
  }
  cvt_range(p.x_prompt, p.Xb, (size_t)T_P * 1024 / 8);
  cvt_range(p.x_sample, p.Xb + (size_t)T_P * 1024, (size_t)1024 * 1024 / 8);
  cvt_range(p.mem_prompt, p.Memb, (size_t)2048 * 1024 / 8);
  cvt_range(p.peer_subkeys, p.SubK, (size_t)262144 / 8);
  for (int i = blockIdx.x * NT + get_tid(); i < 2056 * 64; i += gridDim.x * NT) {
    int pr = i >> 6, j = i & 63;
    int pos = pr < 2048 ? pr : 16384 + (pr - 2048);
    float inv = (float)exp(-((double)j / 64.0) * 9.210340371976184);
    float ang = (float)pos * inv;
    double a = (double)ang;
    double k = rint(a * 0.15915494309189535);
    double r = fma(-k, 6.283185307179586, a);
    r = fma(-k, 2.4492935982947064e-16, r);
    float rf = (float)r;
    float s, c;
    sincosf(rf, &s, &c);
    p.rope_cos[i] = c;
    p.rope_sin[i] = s;
  }
}

typedef unsigned int u32x4 __attribute__((ext_vector_type(4)));
struct Stg { u32x4 a0, a1, b0, b1, b2, b3; };
template <int BCH>
DEVINL void g_load(Stg& s, const u16* Ap, const u16* Bp, int kt) {
  s.a0 = *(const u32x4*)(Ap + kt * 64);
  s.a1 = *(const u32x4*)(Ap + (size_t)64 * 1024 + kt * 64);
  s.b0 = *(const u32x4*)(Bp + kt * 64);
  s.b1 = *(const u32x4*)(Bp + (size_t)64 * 1024 + kt * 64);
  if (BCH == 4) {
    s.b2 = *(const u32x4*)(Bp + (size_t)128 * 1024 + kt * 64);
    s.b3 = *(const u32x4*)(Bp + (size_t)192 * 1024 + kt * 64);
  }
}
template <int BCH>
DEVINL void s_store(const Stg& s, char* da, int lr, int lc) {
  *(u32x4*)(da + sw128(lr, lc)) = s.a0;
  *(u32x4*)(da + sw128(lr + 64, lc)) = s.a1;
  char* db = da + 128 * 128;
  *(u32x4*)(db + sw128(lr, lc)) = s.b0;
  *(u32x4*)(db + sw128(lr + 64, lc)) = s.b1;
  if (BCH == 4) {
    *(u32x4*)(db + sw128(lr + 128, lc)) = s.b2;
    *(u32x4*)(db + sw128(lr + 192, lc)) = s.b3;
  }
}
template <int BN, int NTW>
DEVINL void g_compute(f32x4 (&acc)[4][NTW], const char* sa, int wm, int wn, int l15, int g4) {
  const char* sb = sa + 128 * 128;
#pragma unroll
  for (int ks = 0; ks < 2; ks++) {
    bf16x8 af[4], bfr[NTW];
    const int c = ks * 4 + g4;
#pragma unroll
    for (int mi = 0; mi < 4; mi++) af[mi] = lds_frag(sa + sw128(wm * 64 + mi * 16 + l15, c));
#pragma unroll
    for (int ni = 0; ni < NTW; ni++) bfr[ni] = lds_frag(sb + sw128(wn * (BN / 4) + ni * 16 + l15, c));
#pragma unroll
    for (int mi = 0; mi < 4; mi++)
#pragma unroll
      for (int ni = 0; ni < NTW; ni++) acc[mi][ni] = mfma16(bfr[ni], af[mi], acc[mi][ni]);
  }
}
template <int BN, class Epi>
DEVINL void gemm_tile(const u16* __restrict__ A, const u16* __restrict__ Bt, int m0, int n0, char* smem, Epi epi) {
  constexpr int K = 1024, NKT = 16;
  constexpr int NTW = BN / 64;
  constexpr int STAGE = 128 * 128 + BN * 128;
  constexpr int BCH = BN * 8 / NT;
  const int tid = get_tid(), lane = tid & 63, wid = tid >> 6, wm = wid >> 2, wn = wid & 3;
  const int l15 = lane & 15, g4 = lane >> 4;
  f32x4 acc[4][NTW];
#pragma unroll
  for (int i = 0; i < 4; i++)
#pragma unroll
    for (int j = 0; j < NTW; j++) acc[i][j] = (f32x4){0.f, 0.f, 0.f, 0.f};
  Stg s0, s1;
  const int lr = tid >> 3, lc = tid & 7;
  const u16* Ap = A + (size_t)(m0 + lr) * K + lc * 8;
  const u16* Bp = Bt + (size_t)(n0 + lr) * K + lc * 8;
  g_load<BCH>(s0, Ap, Bp, 0);
  s_store<BCH>(s0, smem, lr, lc);
  g_load<BCH>(s1, Ap, Bp, 1);
  g_load<BCH>(s0, Ap, Bp, 2);
  __syncthreads();
#pragma unroll 4
  for (int kt = 0; kt < NKT; kt += 2) {
    s_store<BCH>(s1, smem + STAGE, lr, lc);
    if (kt + 3 < NKT) g_load<BCH>(s1, Ap, Bp, kt + 3);
    g_compute<BN, NTW>(acc, smem, wm, wn, l15, g4);
    __syncthreads();
    if (kt + 2 < NKT) s_store<BCH>(s0, smem, lr, lc);
    if (kt + 4 < NKT) g_load<BCH>(s0, Ap, Bp, kt + 4);
    g_compute<BN, NTW>(acc, smem + STAGE, wm, wn, l15, g4);
    __syncthreads();
  }
#pragma unroll
  for (int mi = 0; mi < 4; mi++)
#pragma unroll
    for (int ni = 0; ni < NTW; ni++) {
      int m = m0 + wm * 64 + mi * 16 + l15;
      int n = n0 + wn * (BN / 4) + ni * 16 + g4 * 4;
      epi(m, n, acc[mi][ni]);
    }
}

template <int BN, class Coord, class Epi>
DEVINL void gemm_run(const u16* __restrict__ A, const u16* __restrict__ Bt, int t0, int t1, int tstep, Coord coord, char* smem, Epi epi) {
  if (t0 >= t1) return;
  constexpr int K = 1024, NKT = 16;
  constexpr int NTW = BN / 64;
  constexpr int STAGE = 128 * 128 + BN * 128;
  constexpr int BCH = BN * 8 / NT;
  const int tid = get_tid(), lane = tid & 63, wid = tid >> 6, wm = wid >> 2, wn = wid & 3;
  const int l15 = lane & 15, g4 = lane >> 4;
  const int lr = tid >> 3, lc = tid & 7;
  int m0, n0;
  coord(t0, m0, n0);
  const u16* Ap = A + (size_t)(m0 + lr) * K + lc * 8;
  const u16* Bp = Bt + (size_t)(n0 + lr) * K + lc * 8;
  Stg s0, s1;
  g_load<BCH>(s0, Ap, Bp, 0);
  g_load<BCH>(s1, Ap, Bp, 1);
  for (int t = t0; t < t1; t += tstep) {
    f32x4 acc[4][NTW];
#pragma unroll
    for (int i = 0; i < 4; i++)
#pragma unroll
      for (int j = 0; j < NTW; j++) acc[i][j] = (f32x4){0.f, 0.f, 0.f, 0.f};
    s_store<BCH>(s0, smem, lr, lc);
    g_load<BCH>(s0, Ap, Bp, 2);
    __syncthreads();
#pragma unroll 4
    for (int kt = 0; kt < NKT; kt += 2) {
      s_store<BCH>(s1, smem + STAGE, lr, lc);
      if (kt + 3 < NKT) g_load<BCH>(s1, Ap, Bp, kt + 3);
      g_compute<BN, NTW>(acc, smem, wm, wn, l15, g4);
      __syncthreads();
      if (kt + 2 < NKT) s_store<BCH>(s0, smem, lr, lc);
      if (kt + 4 < NKT) g_load<BCH>(s0, Ap, Bp, kt + 4);
      g_compute<BN, NTW>(acc, smem + STAGE, wm, wn, l15, g4);
      __syncthreads();
    }
    const int tn = t + tstep;
    int m0n = m0, n0n = n0;
    if (tn < t1) {
      coord(tn, m0n, n0n);
      Ap = A + (size_t)(m0n + lr) * K + lc * 8;
      Bp = Bt + (size_t)(n0n + lr) * K + lc * 8;
      g_load<BCH>(s0, Ap, Bp, 0);
      g_load<BCH>(s1, Ap, Bp, 1);
    }
#pragma unroll
    for (int mi = 0; mi < 4; mi++)
#pragma unroll
      for (int ni = 0; ni < NTW; ni++) {
        int m = m0 + wm * 64 + mi * 16 + l15;
        int n = n0 + wn * (BN / 4) + ni * 16 + g4 * 4;
        epi(m, n, acc[mi][ni]);
      }
    m0 = m0n; n0 = n0n;
  }
}
DEVINL int first_ge(int bid, int nb, int lo) { return bid >= lo ? bid : bid + ((lo - bid + nb - 1) / nb) * nb; }

DEVINL void ln_phase(const u16* __restrict__ pre, const float* __restrict__ gam, const float* __restrict__ bet,
                     u16* __restrict__ outb) {
  const int tid_ = get_tid(); const int lane = tid_ & 63, wid = __builtin_amdgcn_readfirstlane(tid_ >> 6);
  for (int row = blockIdx.x * 8 + wid; row < T_ALL; row += gridDim.x * 8) {
    float v[16];
    {
      uint4 a = *(const uint4*)(pre + (size_t)row * 1024 + lane * 8);
      uint4 b = *(const uint4*)(pre + (size_t)row * 1024 + 512 + lane * 8);
      unpack8(a, v); unpack8(b, v + 8);
    }
    float s = 0.f;
#pragma unroll
    for (int i = 0; i < 16; i++) s += v[i];
    float mean = wave_sum(s) * (1.0f / 1024.0f);
    float q = 0.f;
#pragma unroll
    for (int i = 0; i < 16; i++) { float d = v[i] - mean; q += d * d; }
    float rstd = rsqrtf(wave_sum(q) * (1.0f / 1024.0f) + LN_EPS_F);
#pragma unroll
    for (int hf = 0; hf < 2; hf++) {
      int col = hf * 512 + lane * 8;
      float4 g0 = *(const float4*)(gam + col), g1 = *(const float4*)(gam + col + 4);
      float4 b0 = *(const float4*)(bet + col), b1 = *(const float4*)(bet + col + 4);
      float y[8];
      const float* o = v + hf * 8;
      y[0] = (o[0] - mean) * rstd * g0.x + b0.x; y[1] = (o[1] - mean) * rstd * g0.y + b0.y;
      y[2] = (o[2] - mean) * rstd * g0.z + b0.z; y[3] = (o[3] - mean) * rstd * g0.w + b0.w;
      y[4] = (o[4] - mean) * rstd * g1.x + b1.x; y[5] = (o[5] - mean) * rstd * g1.y + b1.y;
      y[6] = (o[6] - mean) * rstd * g1.z + b1.z; y[7] = (o[7] - mean) * rstd * g1.w + b1.w;
      *(uint4*)(outb + (size_t)row * 1024 + col) = pack8(y);
    }
  }
}

DEVINL void gate_prompt_item(const Params& p, int id, char* smem) {
  const int tid = get_tid(), lane = tid & 63, wid = tid >> 6, l15 = lane & 15, g4 = lane >> 4;
  const int b = id >> 6, n = (id >> 2) & 15, g = id & 3;
  const int tok0 = b * 2048 + n * 128;
  char* WsL = smem;
  char* VnL = smem + 32768;
  const float* ws = p.w_s + g * 16384;
#pragma unroll
  for (int i = 0; i < 4; i++) {
    int q = tid + i * 512, t = q >> 4, c = q & 15, s0 = c * 8;
    float4 a = *(const float4*)(ws + t * 128 + s0), bb = *(const float4*)(ws + t * 128 + s0 + 4);
    float x[8] = {a.x, a.y, a.z, a.w, bb.x, bb.y, bb.z, bb.w};
#pragma unroll
    for (int j = 0; j < 8; j++) x[j] = (s0 + j <= t) ? x[j] : 0.f;
    *(uint4*)(WsL + sw256(t, c)) = pack8(x);
  }
#pragma unroll
  for (int i = 0; i < 4; i++) {
    int q = tid + i * 512, s = q >> 4, c = q & 15;
    uint4 raw = *(const uint4*)(p.Hb + (size_t)(tok0 + s) * 3072 + 512 + g * 128 + c * 8);
    float x[8]; unpack8(raw, x);
    float sum = 0.f;
#pragma unroll
    for (int j = 0; j < 8; j++) sum += x[j];
    sum += __shfl_xor(sum, 1); sum += __shfl_xor(sum, 2); sum += __shfl_xor(sum, 4); sum += __shfl_xor(sum, 8);
    float mean = sum * (1.0f / 128.0f);
    float var = 0.f;
#pragma unroll
    for (int j = 0; j < 8; j++) { float d = x[j] - mean; var += d * d; }
    var += __shfl_xor(var, 1); var += __shfl_xor(var, 2); var += __shfl_xor(var, 4); var += __shfl_xor(var, 8);
    float rstd = rsqrtf(var * (1.0f / 128.0f) + LN_EPS_F);
    const float* gp = p.gate_ln_g + g * 128 + c * 8;
    const float* bp = p.gate_ln_b + g * 128 + c * 8;
#pragma unroll
    for (int j = 0; j < 8; j++) x[j] = (x[j] - mean) * rstd * gp[j] + bp[j];
    *(uint4*)(VnL + s * 272 + c * 16) = pack8(x);
  }
  __syncthreads();
  f32x4 acc[8];
#pragma unroll
  for (int i = 0; i < 8; i++) acc[i] = (f32x4){0.f, 0.f, 0.f, 0.f};
#pragma unroll
  for (int ks = 0; ks < 4; ks++) {
    bf16x8 af = tr_frag(VnL, 272, 32 * ks, 16 * wid, lane);
#pragma unroll
    for (int ti = 0; ti < 8; ti++) {
      if (32 * ks <= 16 * ti + 15) {
        bf16x8 bw = lds_frag(WsL + sw256(16 * ti + l15, ks * 4 + g4));
        acc[ti] = mfma16(af, bw, acc[ti]);
      }
    }
  }
#pragma unroll
  for (int ti = 0; ti < 8; ti++) {
    int t = 16 * ti + l15, c = 16 * wid + 4 * g4, tok = tok0 + t;
    float bs = p.b_s[g * 128 + t];
    uint2 ua = *(const uint2*)(p.Hb + (size_t)tok * 3072 + g * 128 + c);
    float o0 = bflo(ua.x) * (acc[ti][0] + bs), o1 = bfhi(ua.x) * (acc[ti][1] + bs);
    float o2 = bflo(ua.y) * (acc[ti][2] + bs), o3 = bfhi(ua.y) * (acc[ti][3] + bs);
    uint2 o; o.x = pk2(o0, o1); o.y = pk2(o2, o3);
    *(uint2*)(p.MIXIN + (size_t)tok * 1024 + g * 128 + c) = o;
  }
  __syncthreads();
}

DEVINL void r1_item(const Params& p, int id, char* smem) {
  const int tid = get_tid(), lane = tid & 63, wid = tid >> 6, l15 = lane & 15, g4 = lane >> 4;
  const int b = id >> 6, h = (id >> 4) & 3, n = id & 15;
  const int tok0 = b * 2048 + n * 128;
  char* KL = smem;
  char* VL = smem + 34816;
  const float lg = logf(1.0f - exp2f(-5.0f - (float)h));
#pragma unroll
  for (int i = 0; i < 2; i++) {
    int q = tid + i * 512, j = q >> 3, ch = q & 7;
    int pr = n * 128 + j;
    float cs[8], sn[8];
    {
      float4 c0 = *(const float4*)(p.rope_cos + pr * 64 + ch * 8), c1 = *(const float4*)(p.rope_cos + pr * 64 + ch * 8 + 4);
      float4 s0 = *(const float4*)(p.rope_sin + pr * 64 + ch * 8), s1 = *(const float4*)(p.rope_sin + pr * 64 + ch * 8 + 4);
      cs[0] = c0.x; cs[1] = c0.y; cs[2] = c0.z; cs[3] = c0.w; cs[4] = c1.x; cs[5] = c1.y; cs[6] = c1.z; cs[7] = c1.w;
      sn[0] = s0.x; sn[1] = s0.y; sn[2] = s0.z; sn[3] = s0.w; sn[4] = s1.x; sn[5] = s1.y; sn[6] = s1.z; sn[7] = s1.w;
    }
    u16* rowp = p.Hb + (size_t)(tok0 + j) * 3072;
    {
      u16* qp = rowp + 1024 + h * 128 + ch * 8;
      uint4 a = *(const uint4*)qp, bb = *(const uint4*)(qp + 64);
      float x1[8], x2[8], o1[8], o2[8];
      unpack8(a, x1); unpack8(bb, x2);
#pragma unroll
      for (int e = 0; e < 8; e++) { o1[e] = x1[e] * cs[e] - x2[e] * sn[e]; o2[e] = x1[e] * sn[e] + x2[e] * cs[e]; }
      u16* qo = p.QKR + (size_t)(tok0 + j) * 1024 + h * 128 + ch * 8;
      *(uint4*)qo = pack8(o1);
      *(uint4*)(qo + 64) = pack8(o2);
    }
    {
      u16* kp = rowp + 1536 + h * 128 + ch * 8;
      uint4 a = *(const uint4*)kp, bb = *(const uint4*)(kp + 64);
      float x1[8], x2[8], o1[8], o2[8];
      unpack8(a, x1); unpack8(bb, x2);
      const float sc = 0.08838834764831845f;
#pragma unroll
      for (int e = 0; e < 8; e++) { o1[e] = (x1[e] * cs[e] - x2[e] * sn[e]) * sc; o2[e] = (x1[e] * sn[e] + x2[e] * cs[e]) * sc; }
      u16* ko = p.QKR + (size_t)(tok0 + j) * 1024 + 512 + h * 128 + ch * 8;
      *(uint4*)ko = pack8(o1);
      *(uint4*)(ko + 64) = pack8(o2);
      float dec = __expf(lg * (float)(127 - j));
#pragma unroll
      for (int e = 0; e < 8; e++) { o1[e] *= dec; o2[e] *= dec; }
      *(uint4*)(KL + j * 272 + ch * 16) = pack8(o1);
      *(uint4*)(KL + j * 272 + (ch + 8) * 16) = pack8(o2);
    }
  }
#pragma unroll
  for (int i = 0; i < 4; i++) {
    int q = tid + i * 512, j = q >> 4, c = q & 15;
    *(uint4*)(VL + j * 272 + c * 16) = *(const uint4*)(p.Hb + (size_t)(tok0 + j) * 3072 + 2048 + h * 128 + c * 8);
  }
  __syncthreads();
  f32x4 acc[8];
#pragma unroll
  for (int i = 0; i < 8; i++) acc[i] = (f32x4){0.f, 0.f, 0.f, 0.f};
#pragma unroll
  for (int ks = 0; ks < 4; ks++) {
    bf16x8 af = tr_frag(VL, 272, 32 * ks, 16 * wid, lane);
#pragma unroll
    for (int dt = 0; dt < 8; dt++) {
      bf16x8 bk = tr_frag(KL, 272, 32 * ks, 16 * dt, lane);
      acc[dt] = mfma16(af, bk, acc[dt]);
    }
  }
  float* U = p.U + (size_t)id * 16384;
#pragma unroll
  for (int dt = 0; dt < 8; dt++)
#pragma unroll
    for (int r = 0; r < 4; r++) U[(16 * wid + 4 * g4 + r) * 128 + 16 * dt + l15] = acc[dt][r];
  __syncthreads();
}

DEVINL void ret_sample_item(const Params& p, int id, char* smem) {
  const int tid = get_tid(), lane = tid & 63, wid = tid >> 6;
  const int b = id >> 2, h = id & 3;
  float* qf = (float*)smem;
  float* kf = qf + 1024;
  float* kd = kf + 1024;
  float* vf = kd + 1024;
  float* PL = vf + 1024;
  float* red = PL + 64;
  const float lg = logf(1.0f - exp2f(-5.0f - (float)h));
  {
    int i = tid >> 6, dp = tid & 63;
    int tok = T_P + b * 8 + i, pr = 2048 + i;
    float c = p.rope_cos[pr * 64 + dp], s = p.rope_sin[pr * 64 + dp];
    const u16* rowp = p.Hb + (size_t)tok * 3072;
    float q1 = bf1(rowp[1024 + h * 128 + dp]), q2 = bf1(rowp[1024 + h * 128 + 64 + dp]);
    qf[i * 128 + dp] = q1 * c - q2 * s;
    qf[i * 128 + 64 + dp] = q1 * s + q2 * c;
    const float sc = 0.08838834764831845f;
    float k1 = bf1(rowp[1536 + h * 128 + dp]), k2 = bf1(rowp[1536 + h * 128 + 64 + dp]);
    float ka = (k1 * c - k2 * s) * sc, kb = (k1 * s + k2 * c) * sc;
    kf[i * 128 + dp] = ka; kf[i * 128 + 64 + dp] = kb;
    float dec = __expf(lg * (float)(7 - i));
    kd[i * 128 + dp] = ka * dec; kd[i * 128 + 64 + dp] = kb * dec;
    vf[i * 128 + dp] = bf1(rowp[2048 + h * 128 + dp]);
    vf[i * 128 + 64 + dp] = bf1(rowp[2048 + h * 128 + 64 + dp]);
  }
  __syncthreads();
  if (tid < 64) {
    int i = tid >> 3, j = tid & 7;
    float s = 0.f;
    if (j <= i) {
      for (int d = 0; d < 128; d++) s += qf[i * 128 + d] * kf[j * 128 + d];
      s *= __expf(lg * (float)(i - j));
    }
    PL[tid] = s;
  }
  {
    int e = tid & 127, dq = tid >> 7;
    const float* S0 = p.state_ret + (size_t)(b * 4 + h) * 16384;
    float* Sn = p.new_ret_sample + (size_t)(b * 4 + h) * 16384;
    float part[8], vv[8];
#pragma unroll
    for (int i = 0; i < 8; i++) { part[i] = 0.f; vv[i] = vf[i * 128 + e]; }
    const float c8 = __expf(lg * 8.0f);
    float s0v[32];
#pragma unroll
    for (int dd = 0; dd < 32; dd++) s0v[dd] = S0[(dq * 32 + dd) * 128 + e];
#pragma unroll
    for (int dd = 0; dd < 32; dd++) {
      const int d = dq * 32 + dd;
      float s = s0v[dd];
      float sn = s * c8;
#pragma unroll
      for (int j = 0; j < 8; j++) sn += kd[j * 128 + d] * vv[j];
      Sn[d * 128 + e] = sn;
#pragma unroll
      for (int i = 0; i < 8; i++) part[i] += qf[i * 128 + d] * s;
    }
#pragma unroll
    for (int i = 0; i < 8; i++) red[(dq * 8 + i) * 128 + e] = part[i];
  }
  __syncthreads();
  {
    int i = wid;
    int tok = T_P + b * 8 + i;
    float qdec = __expf(lg * (float)(i + 1));
    float o[2];
#pragma unroll
    for (int hf = 0; hf < 2; hf++) {
      int e = lane + 64 * hf;
      float a = 0.f;
#pragma unroll
      for (int j = 0; j < 8; j++) a += PL[i * 8 + j] * vf[j * 128 + e];
      float r = red[(0 * 8 + i) * 128 + e] + red[(1 * 8 + i) * 128 + e] + red[(2 * 8 + i) * 128 + e] + red[(3 * 8 + i) * 128 + e];
      o[hf] = a + qdec * r;
    }
    float mean = wave_sum(o[0] + o[1]) * (1.0f / 128.0f);
    float d0 = o[0] - mean, d1 = o[1] - mean;
    float rstd = rsqrtf(wave_sum(d0 * d0 + d1 * d1) * (1.0f / 128.0f) + LN_EPS_F);
#pragma unroll
    for (int hf = 0; hf < 2; hf++) {
      int e = lane + 64 * hf;
      float on = (o[hf] - mean) * rstd * p.ret_gn_g[h * 128 + e] + p.ret_gn_b[h * 128 + e];
      float sg = bf1(p.Hb[(size_t)tok * 3072 + 2560 + h * 128 + e]);
      p.MIXIN[(size_t)tok * 1024 + 512 + h * 128 + e] = f2bf(sg * on);
    }
  }
  __syncthreads();
}

DEVINL void gate_sample_item(const Params& p, int b, char* smem) {
  const int tid = get_tid(), lane = tid & 63, wid = tid >> 6;
  float* VS = (float*)smem;
  {
    int s = wid, tok = T_P + b * 8 + s;
    uint4 raw = *(const uint4*)(p.Hb + (size_t)tok * 3072 + 512 + lane * 8);
    float x[8]; unpack8(raw, x);
    float sum = 0.f;
#pragma unroll
    for (int j = 0; j < 8; j++) sum += x[j];
    sum += __shfl_xor(sum, 1); sum += __shfl_xor(sum, 2); sum += __shfl_xor(sum, 4); sum += __shfl_xor(sum, 8);
    float mean = sum * (1.0f / 128.0f);
    float var = 0.f;
#pragma unroll
    for (int j = 0; j < 8; j++) { float d = x[j] - mean; var += d * d; }
    var += __shfl_xor(var, 1); var += __shfl_xor(var, 2); var += __shfl_xor(var, 4); var += __shfl_xor(var, 8);
    float rstd = rsqrtf(var * (1.0f / 128.0f) + LN_EPS_F);
#pragma unroll
    for (int j = 0; j < 8; j++) x[j] = (x[j] - mean) * rstd * p.gate_ln_g[lane * 8 + j] + p.gate_ln_b[lane * 8 + j];
    float* go = p.new_gate_v + (size_t)(b * 8 + s) * 512 + lane * 8;
    *(float4*)go = make_float4(x[0], x[1], x[2], x[3]);
    *(float4*)(go + 4) = make_float4(x[4], x[5], x[6], x[7]);
#pragma unroll
    for (int j = 0; j < 8; j++) VS[s * 512 + lane * 8 + j] = x[j];
  }
  __syncthreads();
  {
    int g = tid >> 7;
    float vs[8];
#pragma unroll
    for (int s = 0; s < 8; s++) vs[s] = VS[s * 512 + tid];
#pragma unroll
    for (int t = 0; t < 8; t++) {
      float mixed = p.b_s[g * 128 + t];
#pragma unroll
      for (int s = 0; s < 8; s++)
        if (s <= t) mixed += p.w_s[g * 16384 + t * 128 + s] * vs[s];
      int tok = T_P + b * 8 + t;
      float ua = bf1(p.Hb[(size_t)tok * 3072 + tid]);
      p.MIXIN[(size_t)tok * 1024 + tid] = f2bf(ua * mixed);
    }
  }
  __syncthreads();
}

DEVINL void ret_scan_item(const Params& p, int id) {
  const int tid = get_tid();
  const int bh = id >> 3, q = (id & 7) * 512 + tid, h = bh & 3;
  const float lg = logf(1.0f - exp2f(-5.0f - (float)h));
  const float c128 = __expf(lg * 128.0f);
  const float4* ub = (const float4*)(p.U + (size_t)(bh * 16) * 16384) + q;
  float4 u[16];
#pragma unroll
  for (int n = 0; n < 16; n++) u[n] = ub[(size_t)n * 4096];
  float4 sv = make_float4(0.f, 0.f, 0.f, 0.f);
  uint2* sp = (uint2*)(p.SP + (size_t)(bh * 16) * 16384) + q;
#pragma unroll
  for (int n = 0; n < 16; n++) {
    uint2 o; o.x = pk2(sv.x, sv.y); o.y = pk2(sv.z, sv.w);
    sp[(size_t)n * 4096] = o;
    sv.x = sv.x * c128 + u[n].x; sv.y = sv.y * c128 + u[n].y; sv.z = sv.z * c128 + u[n].z; sv.w = sv.w * c128 + u[n].w;
  }
  const int e = q >> 5, d4 = (q & 31) * 4;
  float* outp = p.new_ret_prompt + (size_t)bh * 16384;
  outp[(d4 + 0) * 128 + e] = sv.x;
  outp[(d4 + 1) * 128 + e] = sv.y;
  outp[(d4 + 2) * 128 + e] = sv.z;
  outp[(d4 + 3) * 128 + e] = sv.w;
}

DEVINL void r3_item(const Params& p, int id, char* smem) {
  const int tid = get_tid(), lane = tid & 63, wid = tid >> 6, l15 = lane & 15, g4 = lane >> 4;
  const int n = id < 256 ? 15 - (id >> 5) : ((id - 256) >> 5), bh = id & 31, b = bh >> 2, h = bh & 3;
  const int tok0 = b * 2048 + n * 128;
  char* KL = smem;
  char* VL = smem + 32768;
  char* STL = smem + 32768 + 34816;
  const float lg = logf(1.0f - exp2f(-5.0f - (float)h));
  const float c128 = __expf(lg * 128.0f);
#pragma unroll
  for (int i = 0; i < 4; i++) {
    int q = tid + i * 512, j = q >> 4, c = q & 15;
    const u16* rowp = p.Hb + (size_t)(tok0 + j) * 3072;
    *(uint4*)(KL + sw256(j, c)) = *(const uint4*)(p.QKR + (size_t)(tok0 + j) * 1024 + 512 + h * 128 + c * 8);
    *(uint4*)(VL + j * 272 + c * 16) = *(const uint4*)(rowp + 2048 + h * 128 + c * 8);
  }
  {
    const u16* spb = p.SP + (size_t)(bh * 16 + n) * 16384;
#pragma unroll
    for (int i = 0; i < 4; i++) {
      int q = tid + i * 512, e = q >> 4, c = q & 15;
      *(uint4*)(STL + sw256(e, c)) = *(const uint4*)(spb + e * 128 + c * 8);
    }
  }
  const int irow = 16 * wid + l15;
  const u16* qrow = p.Hb + (size_t)(tok0 + irow) * 3072;
  bf16x8 qf[4], qd[4];
  {
    const float qdec = __expf(lg * (float)(irow + 1));
#pragma unroll
    for (int ks = 0; ks < 4; ks++) {
      uint4 raw = *(const uint4*)(p.QKR + (size_t)(tok0 + irow) * 1024 + h * 128 + ks * 32 + 8 * g4);
      qf[ks] = as_frag(raw);
      float x[8]; unpack8(raw, x);
#pragma unroll
      for (int j = 0; j < 8; j++) x[j] *= qdec;
      qd[ks] = as_frag(pack8(x));
    }
  }
  __syncthreads();
  f32x4 pacc[8];
#pragma unroll
  for (int i = 0; i < 8; i++) pacc[i] = (f32x4){0.f, 0.f, 0.f, 0.f};
#pragma unroll
  for (int ks = 0; ks < 4; ks++) {
#pragma unroll
    for (int jt = 0; jt < 8; jt++) {
      if (jt <= wid) {
        bf16x8 kfr = lds_frag(KL + sw256(16 * jt + l15, ks * 4 + g4));
        pacc[jt] = mfma16(kfr, qf[ks], pacc[jt]);
      }
    }
  }
#pragma unroll
  for (int jt = 0; jt < 8; jt++)
#pragma unroll
    for (int r = 0; r < 4; r++) {
      int j = 16 * jt + 4 * g4 + r;
      float v = pacc[jt][r] * __expf(lg * (float)(irow - j));
      pacc[jt][r] = (j <= irow) ? v : 0.f;
    }
  bf16x8 pf[4];
#pragma unroll
  for (int s = 0; s < 4; s++) pf[s] = pack_frag(pacc[2 * s], pacc[2 * s + 1]);
  f32x4 oacc[8];
#pragma unroll
  for (int i = 0; i < 8; i++) oacc[i] = (f32x4){0.f, 0.f, 0.f, 0.f};
#pragma unroll
  for (int s = 0; s < 4; s++) {
    if (2 * s <= wid) {
#pragma unroll
      for (int et = 0; et < 8; et++) {
        bf16x8 vfr = tr_frag_perm(VL, 272, 32 * s, 16 * et, lane);
        oacc[et] = mfma16(vfr, pf[s], oacc[et]);
      }
    }
  }
#pragma unroll
  for (int ks = 0; ks < 4; ks++) {
#pragma unroll
    for (int et = 0; et < 8; et++) {
      bf16x8 sfr = lds_frag(STL + sw256(16 * et + l15, ks * 4 + g4));
      oacc[et] = mfma16(sfr, qd[ks], oacc[et]);
    }
  }
  float sum = 0.f;
#pragma unroll
  for (int et = 0; et < 8; et++) sum += oacc[et][0] + oacc[et][1] + oacc[et][2] + oacc[et][3];
  sum += __shfl_xor(sum, 16); sum += __shfl_xor(sum, 32);
  const float mean = sum * (1.0f / 128.0f);
  float var = 0.f;
#pragma unroll
  for (int et = 0; et < 8; et++)
#pragma unroll
    for (int r = 0; r < 4; r++) { float d = oacc[et][r] - mean; var += d * d; }
  var += __shfl_xor(var, 16); var += __shfl_xor(var, 32);
  const float rstd = rsqrtf(var * (1.0f / 128.0f) + LN_EPS_F);
#pragma unroll
  for (int et = 0; et < 8; et++) {
    int e = 16 * et + 4 * g4;
    float4 gg = *(const float4*)(p.ret_gn_g + h * 128 + e), gb = *(const float4*)(p.ret_gn_b + h * 128 + e);
    uint2 sg = *(const uint2*)(qrow + 2560 + h * 128 + e);
    float o0 = ((oacc[et][0] - mean) * rstd * gg.x + gb.x) * bflo(sg.x);
    float o1 = ((oacc[et][1] - mean) * rstd * gg.y + gb.y) * bfhi(sg.x);
    float o2 = ((oacc[et][2] - mean) * rstd * gg.z + gb.z) * bflo(sg.y);
    float o3 = ((oacc[et][3] - mean) * rstd * gg.w + gb.w) * bfhi(sg.y);
    uint2 o; o.x = pk2(o0, o1); o.y = pk2(o2, o3);
    *(uint2*)(p.MIXIN + (size_t)(tok0 + irow) * 1024 + 512 + h * 128 + e) = o;
  }
  __syncthreads();
}

DEVINL void attn_item(const Params& p, int id, char* smem) {
  const int tid = get_tid(), lane = tid & 63, wid = tid >> 6, l15 = lane & 15, g4 = lane >> 4;
  const bool sample = id >= 512;
  int b, h, tokbase, nvalid;
  if (!sample) { b = id >> 6; h = (id >> 4) & 3; tokbase = b * 2048 + (id & 15) * 128; nvalid = 128; }
  else { int s = id - 512; b = s >> 2; h = s & 3; tokbase = T_P + b * 8; nvalid = 8; }
  if (!sample) {
#pragma unroll 4
    for (int i = 0; i < 16; i++) {
      int q = tid + i * 512, r = q >> 5, c = q & 31;
      *(uint4*)(smem + sw512(r, c)) = *(const uint4*)(p.MemKVb + (size_t)(b * 256 + r) * 2048 + h * 256 + c * 8);
    }
  } else {
#pragma unroll 4
    for (int i = 0; i < 16; i++) {
      int q = tid + i * 512, r = q >> 5, c = q & 31;
      const float* src = p.cache_k + ((size_t)(b * 256 + r) * 4 + h) * 256 + c * 8;
      float4 a = *(const float4*)src, bb = *(const float4*)(src + 4);
      uint4 o; o.x = pk2(a.x, a.y); o.y = pk2(a.z, a.w); o.z = pk2(bb.x, bb.y); o.w = pk2(bb.z, bb.w);
      *(uint4*)(smem + sw512(r, c)) = o;
    }
  }
  __syncthreads();
  const bool active = wid * 16 < nvalid;
  const int irow = wid * 16 + l15;
  const int irc = irow < nvalid ? irow : nvalid - 1;
  const size_t tok = (size_t)(tokbase + irc);
  bf16x8 pf[8];
  float inv_sum = 0.f;
  if (active) {
    const u16* qp = p.QC + tok * 1024 + h * 256 + 8 * g4;
    f32x4 sacc[16];
#pragma unroll
    for (int i = 0; i < 16; i++) sacc[i] = (f32x4){0.f, 0.f, 0.f, 0.f};
    uint4 qcur = *(const uint4*)qp;
#pragma unroll 1
    for (int ks = 0; ks < 8; ks++) {
      uint4 qnext = *(const uint4*)(qp + (ks < 7 ? (ks + 1) * 32 : 0));
      bf16x8 qfr = as_frag(qcur);
#pragma unroll
      for (int mt = 0; mt < 16; mt++) {
        bf16x8 kfr = lds_frag(smem + sw512(16 * mt + l15, ks * 4 + g4));
        sacc[mt] = mfma16(kfr, qfr, sacc[mt]);
      }
      qcur = qnext;
    }
    float mx = -3.0e38f;
#pragma unroll
    for (int mt = 0; mt < 16; mt++)
#pragma unroll
      for (int r = 0; r < 4; r++) mx = fmaxf(mx, sacc[mt][r]);
    mx = fmaxf(mx, __shfl_xor(mx, 16)); mx = fmaxf(mx, __shfl_xor(mx, 32));
    float sum = 0.f;
#pragma unroll
    for (int mt = 0; mt < 16; mt++)
#pragma unroll
      for (int r = 0; r < 4; r++) { float e = __expf(sacc[mt][r] - mx); sacc[mt][r] = e; sum += e; }
    sum += __shfl_xor(sum, 16); sum += __shfl_xor(sum, 32);
    inv_sum = 1.0f / sum;
#pragma unroll
    for (int s = 0; s < 8; s++) pf[s] = pack_frag(sacc[2 * s], sacc[2 * s + 1]);
  }
  __syncthreads();
  if (!sample) {
#pragma unroll 4
    for (int i = 0; i < 16; i++) {
      int q = tid + i * 512, r = q >> 5, c = q & 31;
      *(uint4*)(smem + r * 528 + c * 16) = *(const uint4*)(p.MemKVb + (size_t)(b * 256 + r) * 2048 + 1024 + h * 256 + c * 8);
    }
  } else {
#pragma unroll 4
    for (int i = 0; i < 16; i++) {
      int q = tid + i * 512, r = q >> 5, c = q & 31;
      const float* src = p.cache_v + ((size_t)(b * 256 + r) * 4 + h) * 256 + c * 8;
      float4 a = *(const float4*)src, bb = *(const float4*)(src + 4);
      uint4 o; o.x = pk2(a.x, a.y); o.y = pk2(a.z, a.w); o.z = pk2(bb.x, bb.y); o.w = pk2(bb.z, bb.w);
      *(uint4*)(smem + r * 528 + c * 16) = o;
    }
  }
  __syncthreads();
  if (active) {
    f32x4 oacc[16];
#pragma unroll
    for (int i = 0; i < 16; i++) oacc[i] = (f32x4){0.f, 0.f, 0.f, 0.f};
#pragma unroll
    for (int s = 0; s < 8; s++) {
#pragma unroll
      for (int dt = 0; dt < 16; dt++) {
        bf16x8 vfr = tr_frag_perm(smem, 528, 32 * s, 16 * dt, lane);
        oacc[dt] = mfma16(vfr, pf[s], oacc[dt]);
      }
    }
    if (irow < nvalid) {
#pragma unroll
      for (int dt = 0; dt < 16; dt++) {
        int d = 16 * dt + 4 * g4;
        uint2 o; o.x = pk2(oacc[dt][0] * inv_sum, oacc[dt][1] * inv_sum); o.y = pk2(oacc[dt][2] * inv_sum, oacc[dt][3] * inv_sum);
        *(uint2*)(p.CA + tok * 1024 + h * 256 + d) = o;
      }
    }
  }
  __syncthreads();
}

DEVINL void attn_pair_prompt(const Params& p, int b, int h, int qt0, char* smem) {
  const int tid = get_tid(), lane = tid & 63, wid = tid >> 6, l15 = lane & 15, g4 = lane >> 4;
#pragma unroll 4
  for (int i = 0; i < 16; i++) {
    int q = tid + i * 512, r = q >> 5, c = q & 31;
    *(uint4*)(smem + sw512(r, c)) = *(const uint4*)(p.MemKVb + (size_t)(b * 256 + r) * 2048 + h * 256 + c * 8);
  }
  __syncthreads();
  const int irow = wid * 16 + l15;
  bf16x8 pf[2][8];
  float inv_sum[2];
#pragma unroll
  for (int qq = 0; qq < 2; qq++) {
    const size_t tok = (size_t)(b * 2048 + (qt0 + qq) * 128 + irow);
    const u16* qp = p.QC + tok * 1024 + h * 256 + 8 * g4;
    f32x4 sacc[16];
#pragma unroll
    for (int i = 0; i < 16; i++) sacc[i] = (f32x4){0.f, 0.f, 0.f, 0.f};
    uint4 qcur = *(const uint4*)qp;
#pragma unroll 1
    for (int ks = 0; ks < 8; ks++) {
      uint4 qnext = *(const uint4*)(qp + (ks < 7 ? (ks + 1) * 32 : 0));
      bf16x8 qfr = as_frag(qcur);
#pragma unroll
      for (int mt = 0; mt < 16; mt++) {
        bf16x8 kfr = lds_frag(smem + sw512(16 * mt + l15, ks * 4 + g4));
        sacc[mt] = mfma16(kfr, qfr, sacc[mt]);
        if (mt == 7) __builtin_amdgcn_sched_barrier(0);
      }
      qcur = qnext;
    }
    float mx = -3.0e38f;
#pragma unroll
    for (int mt = 0; mt < 16; mt++)
#pragma unroll
      for (int r = 0; r < 4; r++) mx = fmaxf(mx, sacc[mt][r]);
    mx = fmaxf(mx, __shfl_xor(mx, 16)); mx = fmaxf(mx, __shfl_xor(mx, 32));
    float sum = 0.f;
#pragma unroll
    for (int mt = 0; mt < 16; mt++)
#pragma unroll
      for (int r = 0; r < 4; r++) { float e = __expf(sacc[mt][r] - mx); sacc[mt][r] = e; sum += e; }
    sum += __shfl_xor(sum, 16); sum += __shfl_xor(sum, 32);
    inv_sum[qq] = 1.0f / sum;
#pragma unroll
    for (int s = 0; s < 8; s++) pf[qq][s] = pack_frag(sacc[2 * s], sacc[2 * s + 1]);
    __builtin_amdgcn_sched_barrier(0);
  }
  __syncthreads();
#pragma unroll 4
  for (int i = 0; i < 16; i++) {
    int q = tid + i * 512, r = q >> 5, c = q & 31;
    *(uint4*)(smem + r * 528 + c * 16) = *(const uint4*)(p.MemKVb + (size_t)(b * 256 + r) * 2048 + 1024 + h * 256 + c * 8);
  }
  __syncthreads();
#pragma unroll
  for (int qq = 0; qq < 2; qq++) {
    const size_t tok = (size_t)(b * 2048 + (qt0 + qq) * 128 + irow);
    f32x4 oacc[16];
#pragma unroll
    for (int i = 0; i < 16; i++) oacc[i] = (f32x4){0.f, 0.f, 0.f, 0.f};
#pragma unroll
    for (int s = 0; s < 8; s++) {
#pragma unroll
      for (int dt = 0; dt < 16; dt++) {
        bf16x8 vfr = tr_frag_perm(smem, 528, 32 * s, 16 * dt, lane);
        oacc[dt] = mfma16(vfr, pf[qq][s], oacc[dt]);
        if ((dt & 7) == 7) __builtin_amdgcn_sched_barrier(0);
      }
    }
    const float is = inv_sum[qq];
#pragma unroll
    for (int dt = 0; dt < 16; dt++) {
      int d = 16 * dt + 4 * g4;
      uint2 o; o.x = pk2(oacc[dt][0] * is, oacc[dt][1] * is); o.y = pk2(oacc[dt][2] * is, oacc[dt][3] * is);
      *(uint2*)(p.CA + tok * 1024 + h * 256 + d) = o;
    }
    __builtin_amdgcn_sched_barrier(0);
  }
  __syncthreads();
}

DEVINL int mono(float f) { int b = __float_as_int(f); return b ^ ((b >> 31) & 0x7fffffff); }
DEVINL float unmono(int k) { return __int_as_float(k ^ ((k >> 31) & 0x7fffffff)); }
#define INS16(top, xv) { int _x = (xv); _Pragma("unroll") for (int _k = 0; _k < 16; _k++) { int _h = max(top[_k], _x); _x = min(top[_k], _x); top[_k] = _h; } }

struct CandTab { int a[64], b[64]; };
constexpr CandTab make_cand_tab() {
  CandTab t{};
  int sl = 0;
  for (int a = 0; a < 16; a++)
    for (int bb = 0; bb < 16; bb++)
      if ((a + 1) * (bb + 1) <= 16) { t.a[sl] = a; t.b[sl] = bb; sl++; }
  for (; sl < 64; sl++) { t.a[sl] = -1; t.b[sl] = -1; }
  return t;
}
constexpr CandTab CT = make_cand_tab();

#define CEX(a, b) { int _mx = max(a, b); int _mn = min(a, b); a = _mx; b = _mn; }
DEVINL void sort16_desc(int (&v)[16]) {
#pragma unroll
  for (int k = 2; k <= 16; k <<= 1) {
#pragma unroll
    for (int j = k >> 1; j > 0; j >>= 1) {
#pragma unroll
      for (int i = 0; i < 16; i++) {
        const int l = i ^ j;
        if (l > i) {
          if ((i & k) == 0) { CEX(v[i], v[l]); } else { CEX(v[l], v[i]); }
        }
      }
    }
  }
}
DEVINL void merge16_desc(int (&a)[16], const int (&b)[16]) {
#pragma unroll
  for (int i = 0; i < 16; i++) a[i] = max(a[i], b[15 - i]);
#pragma unroll
  for (int j = 8; j > 0; j >>= 1) {
#pragma unroll
    for (int i = 0; i < 16; i++) {
      const int l = i ^ j;
      if (l > i) { CEX(a[i], a[l]); }
    }
  }
}

DEVINL void topk_load_q(const Params& p, int t, int wid, int l15, int g4, uint4 (&q)[8]) {
  const int tile = t >> 3, h = t & 7;
  const u16* qp = p.PQ + (size_t)(tile * 128 + 16 * wid + l15) * 2048 + h * 256 + 8 * g4;
#pragma unroll
  for (int c = 0; c < 2; c++)
#pragma unroll
    for (int ks = 0; ks < 4; ks++) q[c * 4 + ks] = *(const uint4*)(qp + c * 128 + ks * 32);
}
DEVINL void topk_half(const float* SCw, int tk, int qt, int (&top)[16]) {
  const float* sp = SCw + (size_t)tk * 132 + qt * 32;
#pragma unroll
  for (int grp = 0; grp < 2; grp++) {
    int v[16];
#pragma unroll
    for (int i = 0; i < 4; i++) {
      f32x4 x = *(const f32x4*)(sp + grp * 16 + i * 4);
#pragma unroll
      for (int r = 0; r < 4; r++) {
        int kidx = qt * 32 + grp * 16 + i * 4 + r;
        v[i * 4 + r] = (mono(x[r]) & ~0x7F) | (127 - kidx);
      }
    }
    sort16_desc(v);
    if (grp == 0) {
#pragma unroll
      for (int k = 0; k < 16; k++) top[k] = v[k];
    } else {
      merge16_desc(top, v);
    }
  }
  int b[16];
#pragma unroll
  for (int k = 0; k < 16; k++) b[k] = __shfl_xor(top[k], 16);
  merge16_desc(top, b);
#pragma unroll
  for (int k = 0; k < 16; k++) b[k] = __shfl_xor(top[k], 32);
  merge16_desc(top, b);
}
DEVINL void peer_topk_phase(const Params& p, char* smem) {
  const int tid = get_tid(), lane = tid & 63, wid = __builtin_amdgcn_readfirstlane(tid >> 6), l15 = lane & 15, g4 = lane >> 4;
  const int bid = blockIdx.x, nb = gridDim.x;
  char* SK = smem;
  float* SCw = (float*)(smem + 65536 + wid * 8448);
  int* LI = (int*)SCw;
  int h_loaded = -1;
  uint4 qn[8];
  if (bid < 1088) topk_load_q(p, bid, wid, l15, g4, qn);
  for (int t = bid; t < 1088; t += nb) {
    const int tile = t >> 3, h = t & 7;
    if (h != h_loaded) {
      __syncthreads();
#pragma unroll
      for (int i = 0; i < 8; i++) {
        int q = tid + i * 512, r = q >> 4, c = q & 15;
        *(uint4*)(SK + sw256(r, c)) = *(const uint4*)(p.SubK + (size_t)(h * 256 + r) * 128 + c * 8);
      }
      __syncthreads();
      h_loaded = h;
    }
    uint4 qc[8];
#pragma unroll
    for (int i = 0; i < 8; i++) qc[i] = qn[i];
    if (t + nb < 1088) topk_load_q(p, t + nb, wid, l15, g4, qn);
    const int tok0 = tile * 128 + 16 * wid;
    const int tk = lane & 15, qt = lane >> 4;
    int m0[16], m1[16];
#pragma unroll
    for (int c = 0; c < 2; c++) {
      f32x4 acc[8];
#pragma unroll
      for (int i = 0; i < 8; i++) acc[i] = (f32x4){0.f, 0.f, 0.f, 0.f};
#pragma unroll
      for (int ks = 0; ks < 4; ks++) {
        bf16x8 qfr = as_frag(qc[c * 4 + ks]);
#pragma unroll
        for (int kt = 0; kt < 8; kt++) {
          bf16x8 kfr = lds_frag(SK + sw256(c * 128 + 16 * kt + l15, ks * 4 + g4));
          acc[kt] = mfma16(kfr, qfr, acc[kt]);
        }
      }
      __builtin_amdgcn_wave_barrier();
#pragma unroll
      for (int kt = 0; kt < 8; kt++) *(f32x4*)(SCw + (size_t)l15 * 132 + 16 * kt + 4 * g4) = acc[kt];
      __builtin_amdgcn_wave_barrier();
      if (c == 0) topk_half(SCw, tk, qt, m0); else topk_half(SCw, tk, qt, m1);
      __builtin_amdgcn_wave_barrier();
    }
    if (qt < 2) {
      int* dst = LI + (qt * 16 + tk) * 17;
#pragma unroll
      for (int k = 0; k < 16; k++) dst[k] = qt ? m1[k] : m0[k];
    }
    int top[16];
    {
      float v0[16], v1[16];
#pragma unroll
      for (int k = 0; k < 16; k++) { v0[k] = unmono(m0[k] & ~0x7F); v1[k] = unmono(m1[k] & ~0x7F); }
#pragma unroll
      for (int k = 0; k < 16; k++) {
        int key[4];
#pragma unroll
        for (int g = 0; g < 4; g++) {
          const int ca = CT.a[g * 16 + k], cb = CT.b[g * 16 + k];
          if (ca >= 0) {
            float sm = v0[ca] + v1[cb];
            key[g] = (mono(sm) & ~0xFF) | (255 - (ca * 16 + cb));
          } else {
            key[g] = (int)0x80000000;
          }
        }
        int lo = (qt & 1) ? key[1] : key[0];
        int hi = (qt & 1) ? key[3] : key[2];
        top[k] = (qt & 2) ? hi : lo;
      }
      sort16_desc(top);
      int b[16];
#pragma unroll
      for (int k = 0; k < 16; k++) b[k] = __shfl_xor(top[k], 16);
      merge16_desc(top, b);
#pragma unroll
      for (int k = 0; k < 16; k++) b[k] = __shfl_xor(top[k], 32);
      merge16_desc(top, b);
    }
    __builtin_amdgcn_wave_barrier();
    if (qt == 0) {
      const int* l0 = LI + (0 * 16 + tk) * 17;
      const int* l1 = LI + (1 * 16 + tk) * 17;
      float fv[16];
      float sum = 0.f;
      const float mx = unmono(top[0] & ~0xFF);
#pragma unroll
      for (int k = 0; k < 16; k++) { fv[k] = __expf(unmono(top[k] & ~0xFF) - mx); sum += fv[k]; }
      const float inv = 1.0f / sum;
      const size_t ob = ((size_t)(tok0 + tk) * 8 + h) * 16;
#pragma unroll
      for (int k = 0; k < 16; k++) {
        int code = 255 - (top[k] & 0xFF);
        int a = code >> 4, bb = code & 15;
        int i0 = 127 - (l0[a] & 0x7F), i1 = 127 - (l1[bb] & 0x7F);
        p.SELI[ob + k] = i0 * 128 + i1;
        p.SELG[ob + k] = fv[k] * inv;
      }
    }
    __builtin_amdgcn_wave_barrier();
  }
}

typedef float f32x2 __attribute__((ext_vector_type(2)));
#define DEC16(q, f) { f32x2 t_; \
  t_ = __builtin_amdgcn_cvt_pk_f32_fp8((int)(q).x, false); f[0] = t_[0]; f[1] = t_[1]; t_ = __builtin_amdgcn_cvt_pk_f32_fp8((int)(q).x, true); f[2] = t_[0]; f[3] = t_[1]; \
  t_ = __builtin_amdgcn_cvt_pk_f32_fp8((int)(q).y, false); f[4] = t_[0]; f[5] = t_[1]; t_ = __builtin_amdgcn_cvt_pk_f32_fp8((int)(q).y, true); f[6] = t_[0]; f[7] = t_[1]; \
  t_ = __builtin_amdgcn_cvt_pk_f32_fp8((int)(q).z, false); f[8] = t_[0]; f[9] = t_[1]; t_ = __builtin_amdgcn_cvt_pk_f32_fp8((int)(q).z, true); f[10] = t_[0]; f[11] = t_[1]; \
  t_ = __builtin_amdgcn_cvt_pk_f32_fp8((int)(q).w, false); f[12] = t_[0]; f[13] = t_[1]; t_ = __builtin_amdgcn_cvt_pk_f32_fp8((int)(q).w, true); f[14] = t_[0]; f[15] = t_[1]; }

#ifndef NFP8
#define NFP8 4
#endif
DEVINL void peer_gather_phase(const Params& p) {
  const int tid_ = get_tid(); const int lane = tid_ & 63, wid = __builtin_amdgcn_readfirstlane(tid_ >> 6);
  const int kl = ((lane >> 5) & 1) * 8 + ((lane >> 4) & 1) * 4 + ((lane >> 3) & 1) * 2 + ((lane >> 2) & 1);
  for (int t = blockIdx.x * 8 + wid; t < T_ALL; t += gridDim.x * 8) {
    float x[16], out[16];
    {
      const u16* xr = p.Xb + (size_t)t * 1024 + lane * 16;
      uint4 a = *(const uint4*)xr, b = *(const uint4*)(xr + 8);
      unpack8(a, x); unpack8(b, x + 8);
    }
    float out4[16];
    float sumck = 0.f;
#pragma unroll
    for (int j = 0; j < 16; j++) { out[j] = 0.f; out4[j] = 0.f; }
    int xp[2][2];
    float xs;
    {
      float am = 0.f;
#pragma unroll
      for (int j = 0; j < 16; j++) am = fmaxf(am, fabsf(x[j]));
#pragma unroll
      for (int o = 32; o >= 1; o >>= 1) am = fmaxf(am, __shfl_xor(am, o));
      const float xinv = am > 0.f ? 118.0f / am : 0.f;
      xs = am > 0.f ? am / 118.0f : 0.f;
      unsigned pl[2][2] = {{0u, 0u}, {0u, 0u}};
#pragma unroll
      for (int j = 0; j < 16; j++) {
        const int xi = (int)rintf(x[j] * xinv);
        const int n0 = ((xi + 8) & 15) - 8;
        const int n1 = (xi - n0) >> 4;
        pl[0][j >> 3] |= ((unsigned)n0 & 15u) << (4 * (j & 7));
        pl[1][j >> 3] |= ((unsigned)n1 & 15u) << (4 * (j & 7));
      }
#pragma unroll
      for (int q = 0; q < 2; q++) { xp[q][0] = (int)pl[q][0]; xp[q][1] = (int)pl[q][1]; }
    }
#pragma unroll 1
    for (int h = 0; h < 8; h++) {
      const size_t sb = ((size_t)t * 8 + h) * 16;
      const int ei = p.SELI[sb + (lane & 15)];
      const int ekl = p.SELI[sb + kl];
      const float gk = p.SELG[sb + kl];
      const float us = p.Usc[ekl] * xs, vs = (kl >= NFP8) ? p.Vsc4[ekl] : p.Vsc[ekl];
      float part[16];
      {
        uint2 u[16];
#pragma unroll
        for (int k = 0; k < 16; k++) {
          int e = __builtin_amdgcn_readlane(ei, k);
          u[k] = *(const uint2*)(p.Ub4 + (size_t)e * 512 + lane * 8);
        }
#pragma unroll
        for (int k = 0; k < 16; k++) {
          const int d0 = __builtin_amdgcn_sdot8((int)u[k].x, xp[0][0], __builtin_amdgcn_sdot8((int)u[k].y, xp[0][1], 0, false), false);
          const int d1 = __builtin_amdgcn_sdot8((int)u[k].x, xp[1][0], __builtin_amdgcn_sdot8((int)u[k].y, xp[1][1], 0, false), false);
          part[k] = (float)(d0 + 16 * d1);
        }
      }
      float p8[8], p4[4], p2[2], z;
      {
        const bool hi = (lane & 32) != 0;
#pragma unroll
        for (int k = 0; k < 8; k++) {
          float send = hi ? part[k] : part[k + 8];
          float keep = hi ? part[k + 8] : part[k];
          p8[k] = keep + __shfl_xor(send, 32);
        }
      }
      {
        const bool hi = (lane & 16) != 0;
#pragma unroll
        for (int k = 0; k < 4; k++) {
          float send = hi ? p8[k] : p8[k + 4];
          float keep = hi ? p8[k + 4] : p8[k];
          p4[k] = keep + __shfl_xor(send, 16);
        }
      }
      {
        const bool hi = (lane & 8) != 0;
#pragma unroll
        for (int k = 0; k < 2; k++) {
          float send = hi ? p4[k] : p4[k + 2];
          float keep = hi ? p4[k + 2] : p4[k];
          p2[k] = keep + __shfl_xor(send, 8);
        }
      }
      {
        const bool hi = (lane & 4) != 0;
        float send = hi ? p2[0] : p2[1];
        float keep = hi ? p2[1] : p2[0];
        z = keep + __shfl_xor(send, 4);
      }
      z += __shfl_xor(z, 1);
      z += __shfl_xor(z, 2);
      const float co = gk * gelu_tanh(z * us) * vs;
      {
        uint4 v[NFP8];
#pragma unroll
        for (int k = 0; k < NFP8; k++) {
          int e = __builtin_amdgcn_readlane(ei, k);
          v[k] = *(const uint4*)(p.Vb8 + (size_t)e * 1024 + lane * 16);
        }
#pragma unroll
        for (int k = 0; k < NFP8; k++) {
          const int src = ((k >> 3) & 1) * 32 + ((k >> 2) & 1) * 16 + ((k >> 1) & 1) * 8 + (k & 1) * 4;
          const float ck = __int_as_float(__builtin_amdgcn_readlane(__float_as_int(co), src));
          float f[16];
          DEC16(v[k], f);
#pragma unroll
          for (int j = 0; j < 16; j++) out[j] += ck * f[j];
        }
        __builtin_amdgcn_sched_barrier(0);
      }
      {
        uint2 v[16 - NFP8];
#pragma unroll
        for (int k = 0; k < 16 - NFP8; k++) {
          int e = __builtin_amdgcn_readlane(ei, NFP8 + k);
          v[k] = *(const uint2*)(p.Vb4 + (size_t)e * 512 + lane * 8);
        }
#pragma unroll
        for (int k = 0; k < 16 - NFP8; k++) {
          const int kk = NFP8 + k;
          const int src = ((kk >> 3) & 1) * 32 + ((kk >> 2) & 1) * 16 + ((kk >> 1) & 1) * 8 + (kk & 1) * 4;
          const float ck = __int_as_float(__builtin_amdgcn_readlane(__float_as_int(co), src));
          const unsigned ckb = pk2(ck, 0.f) & 0xffffu;
          union { unsigned u; bf16v2 h; } blo, bhi, tt;
          blo.u = ckb; bhi.u = ckb << 16;
          sumck += __uint_as_float(ckb << 16);
#pragma unroll
          for (int w = 0; w < 2; w++) {
            const unsigned wd = w ? v[k].y : v[k].x;
#pragma unroll
            for (int i = 0; i < 4; i++) {
              tt.u = ((wd >> (4 * i)) & 0x000F000Fu) | 0x43004300u;
              out4[8 * w + i] = __builtin_amdgcn_fdot2_f32_bf16(tt.h, blo.h, out4[8 * w + i], false);
              out4[8 * w + i + 4] = __builtin_amdgcn_fdot2_f32_bf16(tt.h, bhi.h, out4[8 * w + i + 4], false);
            }
          }
        }
        __builtin_amdgcn_sched_barrier(0);
      }
    }
#pragma unroll
    for (int j = 0; j < 16; j++) out[j] += out4[j] - 136.0f * sumck;
    float s = 0.f;
#pragma unroll
    for (int j = 0; j < 16; j++) { out[j] = ALPHA_F * x[j] + out[j]; s += out[j]; }
    const float mean = wave_sum(s) * (1.0f / 1024.0f);
    float q = 0.f;
#pragma unroll
    for (int j = 0; j < 16; j++) { float d = out[j] - mean; q += d * d; }
    const float rstd = rsqrtf(wave_sum(q) * (1.0f / 1024.0f) + LN_EPS_F);
    float* yr = p.Y + (size_t)t * 1024 + lane * 16;
    const float* gp = p.ln3_g + lane * 16;
    const float* bp = p.ln3_b + lane * 16;
#pragma unroll
    for (int i = 0; i < 4; i++) {
      float4 g = *(const float4*)(gp + i * 4), b = *(const float4*)(bp + i * 4);
      float4 y;
      y.x = (out[i * 4 + 0] - mean) * rstd * g.x + b.x; y.y = (out[i * 4 + 1] - mean) * rstd * g.y + b.y;
      y.z = (out[i * 4 + 2] - mean) * rstd * g.z + b.z; y.w = (out[i * 4 + 3] - mean) * rstd * g.w + b.w;
      *(float4*)(yr + i * 4) = y;
    }
  }
}

struct KArgs { const float* in[28]; float* out; char* ws; int flags; int pad; };

constexpr size_t al256(size_t b) { return (b + 255) & ~(size_t)255; }
constexpr size_t OFF_BAR = 0;
constexpr size_t OFF_WINT = OFF_BAR + 16384;
constexpr size_t OFF_WOT = OFF_WINT + al256((size_t)3072 * 1024 * 2);
constexpr size_t OFF_WQT = OFF_WOT + al256((size_t)1024 * 1024 * 2);
constexpr size_t OFF_WKVT = OFF_WQT + al256((size_t)1024 * 1024 * 2);
constexpr size_t OFF_WCOT = OFF_WKVT + al256((size_t)2048 * 1024 * 2);
constexpr size_t OFF_PWQT = OFF_WCOT + al256((size_t)1024 * 1024 * 2);
constexpr size_t OFF_SUBK = OFF_PWQT + al256((size_t)2048 * 1024 * 2);
constexpr size_t OFF_UB = OFF_SUBK + al256((size_t)262144 * 2);
constexpr size_t OFF_VB = OFF_UB + al256((size_t)16384 * 1024 * 2);
constexpr size_t OFF_XB = OFF_VB + al256((size_t)16384 * 1024 * 2);
constexpr size_t OFF_MEMB = OFF_XB + al256((size_t)T_ALL * 1024 * 2);
constexpr size_t OFF_HB = OFF_MEMB + al256((size_t)2048 * 1024 * 2);
constexpr size_t OFF_MEMKVB = OFF_HB + al256((size_t)T_ALL * 3072 * 2);
constexpr size_t OFF_RCOS = OFF_MEMKVB + al256((size_t)2048 * 2048 * 2);
constexpr size_t OFF_RSIN = OFF_RCOS + al256((size_t)2056 * 64 * 4);
constexpr size_t OFF_U = OFF_RSIN + al256((size_t)2056 * 64 * 4);
constexpr size_t OFF_MIXIN = OFF_U + al256((size_t)512 * 16384 * 4);
constexpr size_t OFF_PRE = OFF_MIXIN + al256((size_t)T_ALL * 1024 * 2);
constexpr size_t OFF_XF = OFF_PRE + al256((size_t)T_ALL * 1024 * 4);
constexpr size_t OFF_SELI = OFF_XF + al256((size_t)T_ALL * 1024 * 4);
constexpr size_t OFF_SELG = OFF_SELI + al256((size_t)T_ALL * 128 * 4);
constexpr size_t OFF_QKR = OFF_SELG + al256((size_t)T_ALL * 128 * 4);
constexpr size_t WS_TOTAL = OFF_QKR + al256((size_t)T_P * 1024 * 2);

DEVINL Params make_view(const KArgs& ka) {
  Params p;
  p.x_prompt = ka.in[0]; p.x_sample = ka.in[1]; p.mem_prompt = ka.in[2]; p.cache_k = ka.in[3]; p.cache_v = ka.in[4]; p.state_ret = ka.in[5];
  p.w_in = ka.in[6]; p.w_s = ka.in[7]; p.b_s = ka.in[8]; p.gate_ln_g = ka.in[9]; p.gate_ln_b = ka.in[10]; p.ret_gn_g = ka.in[11];
  p.ret_gn_b = ka.in[12]; p.w_o = ka.in[13]; p.ln1_g = ka.in[14]; p.ln1_b = ka.in[15]; p.ca_wq = ka.in[16]; p.ca_wk = ka.in[17];
  p.ca_wv = ka.in[18]; p.ca_wo = ka.in[19]; p.ln2_g = ka.in[20]; p.ln2_b = ka.in[21]; p.peer_wq = ka.in[22]; p.peer_subkeys = ka.in[23];
  p.peer_u = ka.in[24]; p.peer_v = ka.in[25]; p.ln3_g = ka.in[26]; p.ln3_b = ka.in[27];
  float* o = ka.out;
  p.Y = o;
  p.new_mem_k = o + (size_t)T_ALL * 1024;
  p.new_mem_v = p.new_mem_k + (size_t)2048 * 1024;
  p.new_ret_prompt = p.new_mem_v + (size_t)2048 * 1024;
  p.new_ret_sample = p.new_ret_prompt + (size_t)32 * 16384;
  p.new_gate_v = p.new_ret_sample + (size_t)512 * 16384;
  char* w = ka.ws;
  p.bar = (unsigned*)(w + OFF_BAR);
  p.WinT = (u16*)(w + OFF_WINT); p.WoT = (u16*)(w + OFF_WOT); p.WqT = (u16*)(w + OFF_WQT); p.WkvT = (u16*)(w + OFF_WKVT);
  p.WcoT = (u16*)(w + OFF_WCOT); p.PwqT = (u16*)(w + OFF_PWQT); p.SubK = (u16*)(w + OFF_SUBK); p.Ub = (u16*)(w + OFF_UB);
  p.Vb = (u16*)(w + OFF_VB);
  p.Ub8 = (unsigned char*)(w + OFF_UB); p.Ub4 = p.Ub8; p.Usc = (float*)(w + OFF_UB + (size_t)16384 * 1024);
  p.Vb8 = (unsigned char*)(w + OFF_VB); p.Vsc = (float*)(w + OFF_VB + (size_t)16384 * 1024);
  p.Vb4 = (unsigned char*)(w + OFF_VB + (size_t)20 * 1024 * 1024); p.Vsc4 = (float*)(w + OFF_VB + (size_t)30 * 1024 * 1024); p.Xb = (u16*)(w + OFF_XB); p.Memb = (u16*)(w + OFF_MEMB); p.Hb = (u16*)(w + OFF_HB);
  p.QC = p.Hb; p.PQ = p.Hb + (size_t)T_ALL * 1024;
  p.MemKVb = (u16*)(w + OFF_MEMKVB); p.rope_cos = (float*)(w + OFF_RCOS); p.rope_sin = (float*)(w + OFF_RSIN);
  p.U = (float*)(w + OFF_U); p.MIXIN = (u16*)(w + OFF_MIXIN); p.CA = p.MIXIN; p.PREb = (u16*)(w + OFF_PRE); p.SP = (u16*)(w + OFF_XF);
  p.SELI = (int*)(w + OFF_SELI); p.SELG = (float*)(w + OFF_SELG); p.QKR = (u16*)(w + OFF_QKR);
  return p;
}

__global__ void __launch_bounds__(NT) fwd_megakernel(KArgs ka) {
  __shared__ __attribute__((aligned(16))) char smem[SMEM_BYTES];
  __shared__ uint4 xb_words;
  if (threadIdx.x == 0) xb_words = make_uint4(0u, 0u, 0u, 0u);
  __syncthreads();
  const Params p = make_view(ka);
  XcdBarrier xb = xcd_barrier_post(p.bar, (volatile LAS unsigned*)&xb_words);
  const int bid = blockIdx.x, nb = gridDim.x;
  unsigned epoch = 0;

#if PH(0)
  RPT(0) prep_phase(p, smem);
#endif
  if (ka.flags & 1) cg::this_grid().sync();
  grid_barrier(p, epoch);

#if PH(1)
  {
    gemm_run<256>(p.Xb, p.WinT, bid, 1632, nb, [&](int t, int& m0, int& n0) { int mt = t / 12; m0 = mt * 128; n0 = (t - mt * 12) * 256; }, smem,
      [&](int m, int n, f32x4 v) {
        if (n < 1024) { v[0] = gelu_tanh(v[0]); v[1] = gelu_tanh(v[1]); v[2] = gelu_tanh(v[2]); v[3] = gelu_tanh(v[3]); }
        else if (n >= 2560) { v[0] = silu_f(v[0]); v[1] = silu_f(v[1]); v[2] = silu_f(v[2]); v[3] = silu_f(v[3]); }
        uint2 o; o.x = pk2(v[0], v[1]); o.y = pk2(v[2], v[3]);
        *(uint2*)(p.Hb + (size_t)m * 3072 + n) = o;
      });
    gemm_run<256>(p.Memb, p.WkvT, first_ge(bid, nb, 1632), 1760, nb, [&](int t, int& m0, int& n0) { int u = t - 1632; m0 = (u >> 3) * 128; n0 = (u & 7) * 256; }, smem,
      [&](int m, int n, f32x4 v) {
        float* dst = (n < 1024) ? (p.new_mem_k + (size_t)m * 1024 + n) : (p.new_mem_v + (size_t)m * 1024 + (n - 1024));
        *(f32x4*)dst = v;
        uint2 o; o.x = pk2(v[0], v[1]); o.y = pk2(v[2], v[3]);
        *(uint2*)(p.MemKVb + (size_t)m * 2048 + n) = o;
      });
  }
#endif
  grid_barrier(p, epoch);

#if PH(2)
  RPT(2) for (int t = bid; t < 1664; t += nb) {
    if (t < 512) r1_item(p, t, smem);
    else if (t < 1024) gate_prompt_item(p, t - 512, smem);
    else if (t < 1536) ret_sample_item(p, t - 1024, smem);
    else gate_sample_item(p, t - 1536, smem);
  }
#endif
  grid_barrier(p, epoch);

  for (int t = bid; t < 256; t += nb) ret_scan_item(p, t);
  grid_barrier(p, epoch);

#if PH(3)
  RPT(3) for (int t = bid; t < 512; t += nb) r3_item(p, t, smem);
#endif
  grid_barrier(p, epoch);

#if PH(4)
  {
    auto epi4 = [&](int m, int n, f32x4 v) {
      float4 xr = *(const float4*)(xin_row(p, m) + n);
      uint2 o; o.x = pk2(ALPHA_F * xr.x + v[0], ALPHA_F * xr.y + v[1]); o.y = pk2(ALPHA_F * xr.z + v[2], ALPHA_F * xr.w + v[3]);
      *(uint2*)(p.PREb + (size_t)m * 1024 + n) = o;
    };
    gemm_run<256>(p.MIXIN, p.WoT, bid, 512, nb, [&](int t, int& m0, int& n0) { m0 = (t >> 2) * 128; n0 = (t & 3) * 256; }, smem, epi4);
    gemm_run<128>(p.MIXIN, p.WoT, first_ge(bid, nb, 512), 576, nb, [&](int t, int& m0, int& n0) { int u = t - 512; m0 = (128 + (u >> 3)) * 128; n0 = (u & 7) * 128; }, smem, epi4);
    if (bid >= 64) quant_rows(p, 0, 8936, bid - 64, nb - 64);
  }
#endif
  grid_barrier(p, epoch);

  RPT(5) ln_phase(p.PREb, p.ln1_g, p.ln1_b, p.Xb);
  grid_barrier(p, epoch);

#if PH(6)
  {
    auto epi6 = [&](int m, int n, f32x4 v) {
      uint2 o; o.x = pk2(v[0] * 0.0625f, v[1] * 0.0625f); o.y = pk2(v[2] * 0.0625f, v[3] * 0.0625f);
      *(uint2*)(p.QC + (size_t)m * 1024 + n) = o;
    };
    gemm_run<256>(p.Xb, p.WqT, bid, 512, nb, [&](int t, int& m0, int& n0) { m0 = (t >> 2) * 128; n0 = (t & 3) * 256; }, smem, epi6);
    gemm_run<128>(p.Xb, p.WqT, first_ge(bid, nb, 512), 576, nb, [&](int t, int& m0, int& n0) { int u = t - 512; m0 = (128 + (u >> 3)) * 128; n0 = (u & 7) * 128; }, smem, epi6);
    if (bid >= 64) quant_rows(p, 8936, 17872, bid - 64, nb - 64);
  }
#endif
  grid_barrier(p, epoch);

#if PH(7)
  if ((nb & 1) == 0) {
    const int half = nb >> 1, hb = bid >> 1;
    if ((bid & 1) == 0) {
      for (int u = hb; u < 256; u += half) attn_pair_prompt(p, (u >> 3) >> 2, (u >> 3) & 3, 2 * (u & 7), smem);
    }
    else { for (int t = hb; t < 512; t += half) attn_item(p, 512 + t, smem); }
  } else {
    for (int t = bid; t < 1024; t += nb) attn_item(p, t, smem);
  }
#endif
  grid_barrier(p, epoch);

#if PH(8)
  {
    auto epi8 = [&](int m, int n, f32x4 v) {
      uint2 xr = *(const uint2*)(p.Xb + (size_t)m * 1024 + n);
      uint2 o; o.x = pk2(ALPHA_F * bflo(xr.x) + v[0], ALPHA_F * bfhi(xr.x) + v[1]); o.y = pk2(ALPHA_F * bflo(xr.y) + v[2], ALPHA_F * bfhi(xr.y) + v[3]);
      *(uint2*)(p.PREb + (size_t)m * 1024 + n) = o;
    };
    gemm_run<256>(p.CA, p.WcoT, bid, 512, nb, [&](int t, int& m0, int& n0) { m0 = (t >> 2) * 128; n0 = (t & 3) * 256; }, smem, epi8);
    gemm_run<128>(p.CA, p.WcoT, first_ge(bid, nb, 512), 576, nb, [&](int t, int& m0, int& n0) { int u = t - 512; m0 = (128 + (u >> 3)) * 128; n0 = (u & 7) * 128; }, smem, epi8);
    if (bid >= 64) quant_rows(p, 17872, 26808, bid - 64, nb - 64);
  }
#endif
  grid_barrier(p, epoch);

  RPT(9) ln_phase(p.PREb, p.ln2_g, p.ln2_b, p.Xb);
  grid_barrier(p, epoch);

#if PH(10)
  {
    auto epi10 = [&](int m, int n, f32x4 v) {
      uint2 o; o.x = pk2(v[0], v[1]); o.y = pk2(v[2], v[3]);
      *(uint2*)(p.PQ + (size_t)m * 2048 + n) = o;
    };
    gemm_run<256>(p.Xb, p.PwqT, bid, 1024, nb, [&](int t, int& m0, int& n0) { m0 = (t >> 3) * 128; n0 = (t & 7) * 256; }, smem, epi10);
    gemm_run<128>(p.Xb, p.PwqT, first_ge(bid, nb, 1024), 1152, nb, [&](int t, int& m0, int& n0) { int u = t - 1024; m0 = (128 + (u >> 4)) * 128; n0 = (u & 15) * 128; }, smem, epi10);
    if (bid >= 128) quant_rows(p, 26808, 32768, bid - 128, nb - 128); else if (nb <= 128) quant_rows(p, 26808, 32768, bid, nb);
  }
#endif
  grid_barrier(p, epoch);

#if PH(11)
  __syncthreads();
  RPT(11) peer_topk_phase(p, smem);
#endif
  grid_barrier(p, epoch);

#if PH(12)
  RPT(12) peer_gather_phase(p);
#endif
}

extern "C" void kernel_launch(void* const* d_in, const int* in_sizes, int n_in, void* d_out, int out_size, void* d_ws,
                              size_t ws_size, hipStream_t stream) {
  (void)in_sizes; (void)n_in; (void)out_size;
  KArgs ka;
  memset(&ka, 0, sizeof(ka));
  for (int i = 0; i < 28; i++) ka.in[i] = (const float*)d_in[i];
  ka.out = (float*)d_out;
  ka.ws = (char*)d_ws;
  if (ws_size < WS_TOTAL) fprintf(stderr, "workspace too small: %zu < %zu\n", ws_size, (size_t)WS_TOTAL);
  static int grid_blocks = 0;
  if (!grid_blocks) {
    int dev = 0, cus = 0, per_cu = 0;
    hipGetDevice(&dev);
    hipDeviceGetAttribute(&cus, hipDeviceAttributeMultiprocessorCount, dev);
    hipOccupancyMaxActiveBlocksPerMultiprocessor(&per_cu, fwd_megakernel, NT, 0);
    if (per_cu < 1) per_cu = 1;
    if (per_cu > 1) per_cu = 1;
    grid_blocks = cus * per_cu;
  }
  hipMemsetAsync(ka.ws + OFF_BAR, 0, XCD_BAR_WORDS * 4, stream);
  void* args[] = {&ka};
  hipError_t e = hipLaunchCooperativeKernel((void*)fwd_megakernel, dim3(grid_blocks), dim3(NT), args, 0, stream);
  if (e != hipSuccess) fprintf(stderr, "cooperative launch failed: %s (grid %d)\n", hipGetErrorString(e), grid_blocks);
}
```
